# Optimizing an MI355X kernel written in HIP

```python
import jax, jax.numpy as jnp
from jax import lax
import numpy as np

D_MODEL = 1024
BATCH = 8
SEQ = 2048
DEPTH = 2
DEC_BATCH = 32
DEC_SEQ = 4
PAST_LEN = 8192
PAGE_SIZE = 128

HEAD_DIM = 64
H_FOX = 8
W_FOX = H_FOX * HEAD_DIM
Q_BLOCK = 128
FOX_SCALE = HEAD_DIM ** -0.5
H_RET = 8
RET_DK = 64
RET_DV = 128
W_RET = H_RET * RET_DV
RET_CHUNK = 128
ROPE_BASE = 10000.0
W_MIX0 = W_FOX + W_RET
EVEN_COLS = (W_FOX, W_FOX, W_FOX, H_FOX, W_FOX, H_RET * RET_DK, H_RET * RET_DK, W_RET, W_RET)
EVEN_IN = 4 * W_FOX + H_FOX + 2 * H_RET * RET_DK + 2 * W_RET
GM_WIDTH = 2 * D_MODEL
GM_GROUPS = 8
GM_GC = GM_WIDTH // GM_GROUPS
GM_CHUNK = 128
N_EVEN = (DEPTH + 1) // 2
N_ODD = DEPTH // 2
EPS = 1e-6
F32 = jnp.float32

kernel_name = 'fox_retention_gmlp_hybrid_step'


def _norm(x, g, center):
    xf = x.astype(F32)
    if center:
        xf = xf - jnp.mean(xf, axis=-1, keepdims=True)
    y = xf * lax.rsqrt(jnp.mean(xf * xf, axis=-1, keepdims=True) + EPS)
    return (y * g.astype(F32)).astype(x.dtype)


def rms_norm(x, g):
    return _norm(x, g, False)


def layer_norm(x, g):
    return _norm(x, g, True)


def _split(p, sizes):
    idx = np.cumsum(np.array(sizes))[:-1].tolist()
    return jnp.split(p, idx, axis=-1)


def rope(x, pos):
    half = x.shape[-1] // 2
    inv = ROPE_BASE ** (-jnp.arange(half, dtype=F32) / half)
    ang = pos.astype(F32)[:, None] * inv[None, :]
    cos = jnp.cos(ang)[None, :, None, :]
    sin = jnp.sin(ang)[None, :, None, :]
    xf = x.astype(F32)
    x1, x2 = xf[..., :half], xf[..., half:]
    return jnp.concatenate([x1 * cos - x2 * sin, x1 * sin + x2 * cos], axis=-1).astype(x.dtype)


def ret_log_gamma():
    return jnp.log(1.0 - 2.0 ** (-5.0 - jnp.arange(H_RET, dtype=F32)))


def even_project(x, g_norm, w_in, b_f, g_q, g_k, pos):
    B, L, _ = x.shape
    h = rms_norm(x, g_norm)
    p = jnp.einsum('bld,dc->blc', h, w_in)
    fq, fk, fv, ff, fg, rq, rk, rv, rg = _split(p, EVEN_COLS)
    fq = rms_norm(fq.reshape(B, L, H_FOX, HEAD_DIM), g_q)
    fk = rms_norm(fk.reshape(B, L, H_FOX, HEAD_DIM), g_k)
    fv = fv.reshape(B, L, H_FOX, HEAD_DIM)
    logf = jax.nn.log_sigmoid((ff + b_f).astype(F32))
    rq = rope(rq.reshape(B, L, H_RET, RET_DK), pos)
    rk = rope(rk.reshape(B, L, H_RET, RET_DK), pos) * (RET_DK ** -0.5)
    rv = rv.reshape(B, L, H_RET, RET_DV)
    return fq, fk, fv, logf, fg, rq, rk, rv, rg


def fox_prompt(q, k, v, logf):
    B, S, H, D = q.shape
    nb = S // Q_BLOCK
    c = jnp.cumsum(logf, axis=1).transpose(0, 2, 1)
    qb = jnp.moveaxis(q.reshape(B, nb, Q_BLOCK, H, D), 1, 0)
    cb = jnp.moveaxis(c.reshape(B, H, nb, Q_BLOCK), 2, 0)
    starts = jnp.arange(nb) * Q_BLOCK
    kpos = jnp.arange(S)

    def one_block(args):
        qi, ci, start = args
        s = jnp.einsum('bqhd,bkhd->bhqk', qi, k, preferred_element_type=F32) * FOX_SCALE
        s = s + ci[..., :, None] - c[:, :, None, :]
        qpos = start + jnp.arange(Q_BLOCK)
        s = jnp.where(kpos[None, :] <= qpos[:, None], s, -jnp.inf)
        p = jax.nn.softmax(s, axis=-1).astype(v.dtype)
        return jnp.einsum('bhqk,bkhd->bqhd', p, v)

    o = lax.map(one_block, (qb, cb, starts))
    return jnp.moveaxis(o, 0, 1).reshape(B, S, H, D)


def fox_sample(q, k_new, v_new, logf_new, k_past, v_past, logf_past):
    P = k_past.shape[1]
    L = q.shape[1]
    k_all = jnp.concatenate([k_past.astype(k_new.dtype), k_new], axis=1)
    v_all = jnp.concatenate([v_past.astype(v_new.dtype), v_new], axis=1)
    lf_all = jnp.concatenate([logf_past.astype(F32), logf_new], axis=1)
    c = jnp.cumsum(lf_all, axis=1).transpose(0, 2, 1)
    cq = c[:, :, P:]
    s = jnp.einsum('bqhd,bkhd->bhqk', q, k_all, preferred_element_type=F32) * FOX_SCALE
    s = s + cq[..., :, None] - c[:, :, None, :]
    kpos = jnp.arange(P + L)
    qpos = P + jnp.arange(L)
    s = jnp.where(kpos[None, :] <= qpos[:, None], s, -jnp.inf)
    p = jax.nn.softmax(s, axis=-1).astype(v_all.dtype)
    return jnp.einsum('bhqk,bkhd->bqhd', p, v_all)


def retention_chunk(S_prev, qkv):
    q, k, v = qkv
    L = q.shape[1]
    lg = ret_log_gamma()
    i = jnp.arange(L, dtype=F32)
    diff = i[:, None] - i[None, :]
    decay = jnp.where(diff[None] >= 0, jnp.exp(lg[:, None, None] * jnp.maximum(diff, 0.0)[None]), 0.0)
    qf, kf, vf = q.astype(F32), k.astype(F32), v.astype(F32)
    scores = jnp.einsum('blhd,bmhd->bhlm', qf, kf) * decay[None]
    intra = jnp.einsum('bhlm,bmhe->blhe', scores, vf)
    cross = jnp.einsum('blhd,bhde->blhe', qf, S_prev) * jnp.exp(lg[None, :] * (i[:, None] + 1.0))[None, :, :, None]
    kdec = kf * jnp.exp(lg[None, :] * (L - 1.0 - i)[:, None])[None, :, :, None]
    S_new = jnp.exp(lg * L)[None, :, None, None] * S_prev + jnp.einsum('blhd,blhe->bhde', kdec, vf)
    return S_new, intra + cross


def retention_prompt(q, k, v):
    B, S = q.shape[:2]
    nc = S // RET_CHUNK

    def chunks(t):
        return jnp.moveaxis(t.reshape((B, nc, RET_CHUNK) + t.shape[2:]), 1, 0)

    S0 = jnp.zeros((B, H_RET, RET_DK, RET_DV), F32)
    s_fin, o = lax.scan(retention_chunk, S0, (chunks(q), chunks(k), chunks(v)))
    return jnp.moveaxis(o, 0, 1).reshape(B, S, H_RET, RET_DV), s_fin


def even_output(x, o_fox, o_ret, fg, rg, g_ret, w_out):
    B, L, _ = x.shape
    a = o_fox.astype(x.dtype).reshape(B, L, W_FOX) * jax.nn.silu(fg)
    r = layer_norm(o_ret.astype(x.dtype), g_ret).reshape(B, L, W_RET) * jax.nn.silu(rg)
    m = jnp.concatenate([a, r], axis=-1)
    return x + jnp.einsum('blc,cd->bld', m, w_out)


def odd_project(x, g_norm, w_in, g_v):
    h = rms_norm(x, g_norm)
    p = jnp.einsum('bld,dc->blc', h, w_in)
    u, v, gate = jnp.split(p, 3, axis=-1)
    return jax.nn.gelu(u), layer_norm(jax.nn.gelu(v), g_v), gate


def chunk_spatial(v, w_s, b_s):
    L = v.shape[1]
    w = jnp.where(jnp.tril(jnp.ones((L, L), dtype=bool))[None], w_s[:, :L, :L], 0.0).astype(v.dtype)
    return jnp.einsum('gts,nsgc->ntgc', w, v) + b_s[:, :L].T.astype(v.dtype)[None, :, :, None]


def odd_output(x, u, sv, gate, w_out):
    return x + jnp.einsum('blc,cd->bld', u * sv * jax.nn.silu(gate), w_out)


def setup_inputs(seed: int = 0) -> dict:
    key = jax.random.key(seed)
    ks = jax.random.split(key, 24)
    n_pages = PAST_LEN // PAGE_SIZE
    n_used = DEC_BATCH * n_pages
    n_phys = n_used + max(1, n_used // 4)
    perm = jax.random.permutation(ks[0], n_phys)
    page_table = perm[:n_used].reshape(DEC_BATCH, n_pages).astype(jnp.int32)
    nrm = jax.random.normal
    return {
        'x_prompt': nrm(ks[1], (BATCH, SEQ, D_MODEL), F32),
        'x_sample': nrm(ks[2], (DEC_BATCH, DEC_SEQ, D_MODEL), F32),
        'cache_k': nrm(ks[3], (N_EVEN, n_phys, PAGE_SIZE, H_FOX, HEAD_DIM), F32),
        'cache_v': nrm(ks[4], (N_EVEN, n_phys, PAGE_SIZE, H_FOX, HEAD_DIM), F32),
        'cache_logf': jax.nn.log_sigmoid(jax.random.uniform(ks[5], (N_EVEN, n_phys, PAGE_SIZE, H_FOX), F32, 1.0, 6.0)),
        'state_ret': 0.5 * nrm(ks[6], (N_EVEN, DEC_BATCH, H_RET, RET_DK, RET_DV), F32),
        'page_table': page_table,
        'norm_even': 1.0 + 0.05 * nrm(ks[7], (N_EVEN, D_MODEL), F32),
        'w_in_even': nrm(ks[8], (N_EVEN, D_MODEL, EVEN_IN), F32) * D_MODEL ** -0.5,
        'b_forget': jax.random.uniform(ks[9], (N_EVEN, H_FOX), F32, 1.0, 6.0),
        'qnorm': 1.0 + 0.05 * nrm(ks[10], (N_EVEN, HEAD_DIM), F32),
        'knorm': 1.0 + 0.05 * nrm(ks[11], (N_EVEN, HEAD_DIM), F32),
        'ret_norm': 1.0 + 0.05 * nrm(ks[12], (N_EVEN, H_RET, RET_DV), F32),
        'w_out_even': nrm(ks[13], (N_EVEN, W_MIX0, D_MODEL), F32) * W_MIX0 ** -0.5,
        'norm_odd': 1.0 + 0.05 * nrm(ks[14], (N_ODD, D_MODEL), F32),
        'w_in_odd': nrm(ks[15], (N_ODD, D_MODEL, 3 * GM_WIDTH), F32) * D_MODEL ** -0.5,
        'vnorm_odd': 1.0 + 0.05 * nrm(ks[16], (N_ODD, GM_WIDTH), F32),
        'w_spatial': nrm(ks[17], (N_ODD, GM_GROUPS, GM_CHUNK, GM_CHUNK), F32) * GM_CHUNK ** -0.5,
        'b_spatial': 1.0 + 0.1 * nrm(ks[18], (N_ODD, GM_GROUPS, GM_CHUNK), F32),
        'w_out_odd': nrm(ks[19], (N_ODD, GM_WIDTH, D_MODEL), F32) * GM_WIDTH ** -0.5,
    }


def reference(x_prompt, x_sample, cache_k, cache_v, cache_logf, state_ret, page_table,
              norm_even, w_in_even, b_forget, qnorm, knorm, ret_norm, w_out_even,
              norm_odd, w_in_odd, vnorm_odd, w_spatial, b_spatial, w_out_odd):
    Bp, S, _ = x_prompt.shape
    Bd, L, _ = x_sample.shape
    n_pages = page_table.shape[1]
    P = n_pages * PAGE_SIZE
    pos_p = jnp.arange(S)
    pos_d = P + jnp.arange(L)
    xp, xd = x_prompt, x_sample
    k_p, v_p, lf_p, sr_p = [], [], [], []
    k_d, v_d, lf_d, sr_d, gv_d = [], [], [], [], []
    for layer in range(DEPTH):
        i = layer // 2
        if layer % 2 == 0:
            fq, fk, fv, logf, fg, rq, rk, rv, rg = even_project(
                xp, norm_even[i], w_in_even[i], b_forget[i], qnorm[i], knorm[i], pos_p)
            o_f = fox_prompt(fq, fk, fv, logf)
            o_r, s_fin = retention_prompt(rq, rk, rv)
            xp = even_output(xp, o_f, o_r, fg, rg, ret_norm[i], w_out_even[i])
            k_p.append(fk)
            v_p.append(fv)
            lf_p.append(logf.astype(x_prompt.dtype))
            sr_p.append(s_fin.astype(x_prompt.dtype))
            fq, fk, fv, logf, fg, rq, rk, rv, rg = even_project(
                xd, norm_even[i], w_in_even[i], b_forget[i], qnorm[i], knorm[i], pos_d)
            kpast = cache_k[i][page_table].reshape(Bd, P, H_FOX, HEAD_DIM)
            vpast = cache_v[i][page_table].reshape(Bd, P, H_FOX, HEAD_DIM)
            lfpast = cache_logf[i][page_table].reshape(Bd, P, H_FOX)
            o_f = fox_sample(fq, fk, fv, logf, kpast, vpast, lfpast)
            s_new, o_r = retention_chunk(state_ret[i].astype(F32), (rq, rk, rv))
            xd = even_output(xd, o_f, o_r, fg, rg, ret_norm[i], w_out_even[i])
            k_d.append(fk)
            v_d.append(fv)
            lf_d.append(logf.astype(x_sample.dtype))
            sr_d.append(s_new.astype(x_sample.dtype))
        else:
            u, v, gate = odd_project(xp, norm_odd[i], w_in_odd[i], vnorm_odd[i])
            sv = chunk_spatial(v.reshape(Bp * (S // GM_CHUNK), GM_CHUNK, GM_GROUPS, GM_GC),
                               w_spatial[i], b_spatial[i]).reshape(Bp, S, GM_WIDTH)
            xp = odd_output(xp, u, sv, gate, w_out_odd[i])
            u, v, gate = odd_project(xd, norm_odd[i], w_in_odd[i], vnorm_odd[i])
            sv = chunk_spatial(v.reshape(Bd, L, GM_GROUPS, GM_GC),
                               w_spatial[i], b_spatial[i]).reshape(Bd, L, GM_WIDTH)
            xd = odd_output(xd, u, sv, gate, w_out_odd[i])
            gv_d.append(v)
    return (xp, xd, jnp.stack(k_p), jnp.stack(v_p), jnp.stack(lf_p), jnp.stack(sr_p),
            jnp.stack(k_d), jnp.stack(v_d), jnp.stack(lf_d), jnp.stack(sr_d), jnp.stack(gv_d))
```

```cpp
#include <hip/hip_runtime.h>
#include <hip/hip_bf16.h>
#include <cstdio>
#include <cstdint>
#include <cmath>

namespace pg8 {
#define PG8_LAS __attribute__((address_space(3)))
typedef unsigned short bf16_t;
typedef short bf16x8 __attribute__((ext_vector_type(8)));
typedef float f32x4 __attribute__((ext_vector_type(4)));
typedef unsigned u32x4 __attribute__((ext_vector_type(4)));
constexpr int BM = 256, BK = 64, HALF = 128, HTB = HALF * BK * 2  , STAGE_BYTES = 8 * HTB, NXCD = 8, WGM = 8;

__host__ __device__ __forceinline__ int lds_byte(int r, int c) { const int st = (r >> 4) * 2 + (c >> 5), rr = r & 15, cc = c & 31, ob = rr * 64 + cc * 2; return st * 1024 + (ob ^ (((ob >> 9) & 1) << 5)); }
__host__ __device__ __forceinline__ void stage_rc(int b, int& R, int& C) { const int st = b / 1024, sb = b % 1024, swz = sb ^ (((sb >> 9) & 1) << 5); R = (st >> 1) * 16 + swz / 64; C = (st & 1) * 32 + (swz % 64) / 2; }
__host__ __device__ __forceinline__ int perm32(int rho) { const int n = rho >> 4, i = rho & 15; return 8 * (i >> 2) + 4 * n + (i & 3); }

struct Unit { int pm, pn; };
struct Gemm { const bf16_t* A; const bf16_t* Bt; int M, N, K; };

struct StaticOrder {
    int nM, nN, nwg, G, c;
    __host__ __device__ void init(int M, int N, int G_, int c_) { nM = M / BM; nN = N / BM; nwg = nM * nN; G = G_; c = c_; }
    __host__ __device__ bool next(int i, Unit& u) const {
        const long L = (long)i * G + c; if (L >= nwg) return false;
        int wgid = (int)L; { const int q = nwg / NXCD, r = nwg % NXCD, xcd = wgid % NXCD, off = wgid / NXCD; wgid = (xcd < r ? xcd * (q + 1) : r * (q + 1) + (xcd - r) * q) + off; }
        const int nig = WGM * nN, gid = wgid / nig, fm = gid * WGM, gsz = (nM - fm) < WGM ? (nM - fm) : WGM;
        u.pm = fm + ((wgid % nig) % gsz); u.pn = (wgid % nig) / gsz; return true;
    }
    __device__ __forceinline__ void a_ready(const Unit&) const {}
    __device__ __forceinline__ void done(const Unit&) const {}
};

__device__ __forceinline__ unsigned cvt_pk_bf16(float lo, float hi) { unsigned r; asm volatile("v_cvt_pk_bf16_f32 %0, %1, %2" : "=v"(r) : "v"(lo), "v"(hi)); return r; }
typedef float f32x2 __attribute__((ext_vector_type(2)));

template <class Epi, class Sched, bool ALIGN_EPI = false, bool SP2 = false>
__device__ __forceinline__ void gemm_phase(PG8_LAS unsigned char* lds, const Gemm g, const Sched& S, const Epi& E) {
    const int tid = threadIdx.x, wid = __builtin_amdgcn_readfirstlane(tid >> 6), lane = tid & 63, wr = wid >> 2, wc = wid & 3, fr = lane & 15, fq = lane >> 4;
    const int K = g.K, nt = K / BK;
    unsigned voffA[2], voffB[2];
#pragma unroll
    for (int i = 0; i < 2; ++i) { int R, C; stage_rc(tid * 16 + i * 8192, R, C); const int Rb = Epi::PERM ? ((R & ~31) + perm32(R & 31)) : R;
        voffA[i] = (unsigned)(R * K + C) * 2u; voffB[i] = (unsigned)(Rb * K + C) * 2u; }
    const size_t kstep = (size_t)(BK * 2);
    const size_t hstep = (size_t)HALF * K * 2;
    const size_t tstep = 2 * hstep;
    const unsigned ldsw = (unsigned)wid * 1024u;
    const int aoff = lds_byte(wr * 64 + fr, fq * 8), boff = lds_byte(wc * 32 + fr, fq * 8);
#define PG8_SA(b, h) (((b) * 2 + (h)) * HTB)
#define PG8_SB(b, h) ((4 + (b) * 2 + (h)) * HTB)
#define PG8_STAGE(bufoff, gbase, voff) do { _Pragma("unroll") for (int _i = 0; _i < 2; ++_i) \
        __builtin_amdgcn_global_load_lds((const unsigned*)((const char*)(gbase) + (voff)[_i]), (PG8_LAS unsigned*)(lds + (bufoff) + ldsw + _i * 8192), 16, 0, 0); } while (0)
#define PG8_LDA(dst, b, h) do { _Pragma("unroll") for (int m = 0; m < 4; ++m) _Pragma("unroll") for (int k = 0; k < 2; ++k) dst[m][k] = *(const PG8_LAS bf16x8*)(lds + PG8_SA(b, h) + aoff + m * 2048 + k * 1024); } while (0)
#define PG8_LDB(dst, b, h) do { _Pragma("unroll") for (int n = 0; n < 2; ++n) _Pragma("unroll") for (int k = 0; k < 2; ++k) dst[n][k] = *(const PG8_LAS bf16x8*)(lds + PG8_SB(b, h) + boff + n * 2048 + k * 1024); } while (0)
#define PG8_MMA(ai, bj, At, Bt) do { __builtin_amdgcn_s_setprio(1); _Pragma("unroll") for (int m = 0; m < 4; ++m) _Pragma("unroll") for (int n = 0; n < 2; ++n) _Pragma("unroll") for (int k = 0; k < 2; ++k) \
        acc[ai][bj][m][n] = __builtin_amdgcn_mfma_f32_16x16x32_bf16(Bt[n][k], At[m][k], acc[ai][bj][m][n], 0, 0, 0); __builtin_amdgcn_s_setprio(0); } while (0)
#define PG8_WAIT_V(n) asm volatile("s_waitcnt vmcnt(" #n ")" ::: "memory")
#define PG8_WAIT_L(n) asm volatile("s_waitcnt lgkmcnt(" #n ")" ::: "memory")
#define PG8_BAR __builtin_amdgcn_s_barrier()
#define PG8_SCHED __builtin_amdgcn_sched_barrier(0)
    Unit cur, nxt; int ui = 0;
    if (!S.next(0, cur)) return;
    f32x4 acc[2][2][4][2];
#pragma unroll
    for (int a = 0; a < 2; ++a)
#pragma unroll
        for (int b = 0; b < 2; ++b)
#pragma unroll
            for (int m = 0; m < 4; ++m)
#pragma unroll
                for (int n = 0; n < 2; ++n) acc[a][b][m][n] = (f32x4){0.f, 0.f, 0.f, 0.f};
    bf16x8 At[4][2], B0[2][2], B1[2][2];
    const char* cA = (const char*)g.A + (size_t)cur.pm * tstep; const char* cB = (const char*)g.Bt + (size_t)cur.pn * tstep;
    S.a_ready(cur);
    if constexpr (SP2) {
        PG8_STAGE(PG8_SB(0, 0), cB, voffB); PG8_STAGE(PG8_SB(0, 1), cB + hstep, voffB); PG8_STAGE(PG8_SA(0, 0), cA, voffA); PG8_STAGE(PG8_SA(0, 1), cA + hstep, voffA);
        if (wr == 1) PG8_BAR;
        PG8_WAIT_V(2); PG8_BAR;
        PG8_STAGE(PG8_SB(1, 0), cB + kstep, voffB); PG8_STAGE(PG8_SA(1, 0), cA + kstep, voffA); PG8_STAGE(PG8_SB(1, 1), cB + hstep + kstep, voffB);
        PG8_WAIT_V(6); PG8_BAR;
    } else {
        PG8_STAGE(PG8_SB(0, 0), cB, voffB); PG8_STAGE(PG8_SA(0, 0), cA, voffA); PG8_STAGE(PG8_SB(0, 1), cB + hstep, voffB); PG8_STAGE(PG8_SA(0, 1), cA + hstep, voffA);
        if (wr == 1) PG8_BAR;
        PG8_WAIT_V(4); PG8_BAR;
        PG8_STAGE(PG8_SB(1, 0), cB + kstep, voffB); PG8_STAGE(PG8_SA(1, 0), cA + kstep, voffA); PG8_STAGE(PG8_SB(1, 1), cB + hstep + kstep, voffB);
        PG8_WAIT_V(6); PG8_BAR;
    }
    for (;;) {
        const bool has_next = S.next(ui + 1, nxt);
        const char* nA = has_next ? (const char*)g.A + (size_t)nxt.pm * tstep : cA; const char* nB = has_next ? (const char*)g.Bt + (size_t)nxt.pn * tstep : cB;
        for (int t = 0; t < nt; t += 2) {
            const bool last = (t == nt - 2);
            const char* a1 = cA + (size_t)(t + 1) * kstep;
            const char* a2 = last ? nA : cA + (size_t)(t + 2) * kstep; const char* b2 = last ? nB : cB + (size_t)(t + 2) * kstep;
            const char* a3 = a2 + kstep; const char* b3 = b2 + kstep;
            if (last && has_next) S.a_ready(nxt);
            if constexpr (SP2) {
            PG8_LDB(B0, 0, 0); PG8_LDB(B1, 0, 1); PG8_SCHED; PG8_LDA(At, 0, 0); PG8_STAGE(PG8_SA(1, 1), a1 + hstep, voffA);
            PG8_WAIT_V(8); PG8_WAIT_L(0); PG8_BAR; PG8_MMA(0, 0, At, B0); PG8_MMA(0, 1, At, B1); PG8_BAR; PG8_SCHED;
            PG8_LDA(At, 0, 1); PG8_STAGE(PG8_SB(0, 0), b2, voffB); PG8_STAGE(PG8_SB(0, 1), b2 + hstep, voffB); PG8_STAGE(PG8_SA(0, 0), a2, voffA);
            PG8_WAIT_V(8); PG8_WAIT_L(0); PG8_BAR; PG8_MMA(1, 0, At, B0); PG8_MMA(1, 1, At, B1); PG8_BAR; PG8_SCHED;
            PG8_LDB(B0, 1, 0); PG8_LDB(B1, 1, 1); PG8_SCHED; PG8_LDA(At, 1, 0); PG8_STAGE(PG8_SA(0, 1), a2 + hstep, voffA);
            PG8_WAIT_V(8); PG8_WAIT_L(0); PG8_BAR; PG8_MMA(0, 0, At, B0); PG8_MMA(0, 1, At, B1); PG8_BAR; PG8_SCHED;
            PG8_LDA(At, 1, 1); PG8_STAGE(PG8_SB(1, 0), b3, voffB); PG8_STAGE(PG8_SB(1, 1), b3 + hstep, voffB); PG8_STAGE(PG8_SA(1, 0), a3, voffA);
            PG8_WAIT_V(8); PG8_WAIT_L(0); PG8_BAR; PG8_MMA(1, 0, At, B0); PG8_MMA(1, 1, At, B1); PG8_BAR; PG8_SCHED;
            } else {
            PG8_LDB(B0, 0, 0); PG8_SCHED; PG8_LDA(At, 0, 0); PG8_STAGE(PG8_SA(1, 1), a1 + hstep, voffA);
            PG8_WAIT_L(8); PG8_BAR; PG8_WAIT_L(0); PG8_MMA(0, 0, At, B0); PG8_BAR; PG8_SCHED;
            PG8_LDB(B1, 0, 1); PG8_STAGE(PG8_SB(0, 0), b2, voffB);
            PG8_BAR; PG8_WAIT_L(0); PG8_MMA(0, 1, At, B1); PG8_BAR;
            PG8_LDA(At, 0, 1); PG8_STAGE(PG8_SA(0, 0), a2, voffA);
            PG8_BAR; PG8_WAIT_L(0); PG8_MMA(1, 0, At, B0); PG8_BAR; PG8_SCHED;
            PG8_STAGE(PG8_SB(0, 1), b2 + hstep, voffB);
            PG8_WAIT_V(6); PG8_BAR; PG8_MMA(1, 1, At, B1); PG8_BAR;
            PG8_LDB(B0, 1, 0); PG8_SCHED; PG8_LDA(At, 1, 0); PG8_STAGE(PG8_SA(0, 1), a2 + hstep, voffA);
            PG8_WAIT_L(8); PG8_BAR; PG8_WAIT_L(0); PG8_MMA(0, 0, At, B0); PG8_BAR; PG8_SCHED;
            PG8_LDB(B1, 1, 1); PG8_STAGE(PG8_SB(1, 0), b3, voffB);
            PG8_BAR; PG8_WAIT_L(0); PG8_MMA(0, 1, At, B1); PG8_BAR;
            PG8_LDA(At, 1, 1); PG8_STAGE(PG8_SA(1, 0), a3, voffA);
            PG8_BAR; PG8_WAIT_L(0); PG8_MMA(1, 0, At, B0); PG8_BAR; PG8_SCHED;
            PG8_STAGE(PG8_SB(1, 1), b3 + hstep, voffB);
            PG8_WAIT_V(6); PG8_BAR; PG8_MMA(1, 1, At, B1); PG8_BAR;
            }
        }
        if constexpr (ALIGN_EPI) { if (wr == 0) PG8_BAR; }
        if constexpr (!Epi::AFTER_DRAIN) { E(acc, cur, wr, wc, fr, fq); S.done(cur); }
        if (!has_next) break;
#pragma unroll
        for (int a = 0; a < 2; ++a)
#pragma unroll
            for (int b = 0; b < 2; ++b)
#pragma unroll
                for (int m = 0; m < 4; ++m)
#pragma unroll
                    for (int n = 0; n < 2; ++n) acc[a][b][m][n] = (f32x4){0.f, 0.f, 0.f, 0.f};
        cur = nxt; cA = nA; cB = nB; ++ui;
        if constexpr (ALIGN_EPI) { if (wr == 1) PG8_BAR; }
    }
    PG8_WAIT_V(0);
    if constexpr (!ALIGN_EPI) { if (wr == 0) PG8_BAR; }
    PG8_BAR;
    if constexpr (Epi::AFTER_DRAIN) { E.fused(acc, cur, wr, wc, fr, fq, lds, wid, lane); S.done(cur); }
#undef PG8_SA
#undef PG8_SB
#undef PG8_STAGE
#undef PG8_LDA
#undef PG8_LDB
#undef PG8_MMA
#undef PG8_WAIT_V
#undef PG8_WAIT_L
#undef PG8_BAR
#undef PG8_SCHED
}
}

namespace attn_body {
using bf16=__hip_bfloat16;
using bf16x8=__attribute__((ext_vector_type(8)))short;
using s16x4=__attribute__((ext_vector_type(4)))short;
using f32x16=__attribute__((ext_vector_type(16)))float;
using u32x4=__attribute__((ext_vector_type(4)))unsigned;
using f32x4v=__attribute__((ext_vector_type(4)))float;
constexpr int BATCH=8,NHEAD=8,SEQ=2048,D=64,DM=NHEAD*D,MXP=1536;
constexpr int NW=8,QBLK=32,QB=QBLK*NW,KVBLK=64,NQB=SEQ/QB;
constexpr int ATTN_PITCH=DM, ATTN_UNIT_ROWS=QB;
__device__ __forceinline__ int crow(int r,int hi){return (r&3)+8*(r>>2)+4*hi;}
#define SBAR() __builtin_amdgcn_sched_barrier(0)
__device__ __forceinline__ void cmask(f32x16&p0,f32x16&p1,int jb,int qrel,int hi){
  const float NEG=-INFINITY; const int lim=qrel-64*jb-4*hi;
  #pragma unroll
  for(int r=0;r<16;++r){const int kv=(r&3)+8*(r>>2); if(kv>lim)p0[r]=NEG; if(kv+32>lim)p1[r]=NEG;}
}

constexpr int NSLOT=3, SLOTB=8192;
constexpr int LDS_K=0, LDS_V=NSLOT*SLOTB, LDS_WS=2*NSLOT*SLOTB, LDS_OST=LDS_WS+NW*64*4, LDS_BYTES=LDS_OST+NW*4096;
constexpr float C2=0.125f*1.4426950408889634f;
__device__ __forceinline__ void glds16(const void*gsrc,unsigned lds_dst){unsigned keep;
  asm volatile("s_mov_b32 %0, m0\n\ts_mov_b32 m0, %2\n\ts_nop 0\n\tglobal_load_lds_dwordx4 %1, off\n\ts_mov_b32 m0, %0":"=&s"(keep):"v"(gsrc),"s"(lds_dst):"memory");}
__device__ __forceinline__ float max3f(float a,float b,float c){float r;asm("v_max3_f32 %0, %1, %2, %3":"=v"(r):"v"(a),"v"(b),"v"(c));return r;}
__device__ __forceinline__ float max2f(float a,float b){float r;asm("v_max_f32_e32 %0, %1, %2":"=v"(r):"v"(a),"v"(b));return r;}
__device__ __forceinline__ float fadd_s(float a,float b){float r;asm("v_add_f32_e32 %0, %1, %2":"=v"(r):"v"(a),"v"(b));return r;}
__device__ __forceinline__ float fsub_s(float a,float b){float r;asm("v_sub_f32_e32 %0, %1, %2":"=v"(r):"v"(a),"v"(b));return r;}
typedef float f32x2_t __attribute__((ext_vector_type(2))); typedef __bf16 bf16x2_t __attribute__((ext_vector_type(2)));
__device__ __forceinline__ unsigned cvtpk_s(float lo,float hi){f32x2_t v={lo,hi};bf16x2_t b=__builtin_convertvector(v,bf16x2_t);return __builtin_bit_cast(unsigned,b);}
#define WAIT_BAR(N) asm volatile("s_waitcnt vmcnt(" #N ") lgkmcnt(0)\n\ts_barrier":::"memory")

__device__ __forceinline__ void qkt(f32x16&p0,f32x16&p1,const char*Kslot,const bf16x8*qr,int r32,int hi){
  const char*kb=Kslot+hi*1024+r32*16;
  #pragma unroll
  for(int d0=0;d0<4;++d0){
    const bf16x8 b0=*reinterpret_cast<const bf16x8*>(kb+d0*2048);
    const bf16x8 b1=*reinterpret_cast<const bf16x8*>(kb+d0*2048+512);
    p0=__builtin_amdgcn_mfma_f32_32x32x16_bf16(b0,qr[d0],p0,0,0,0);p1=__builtin_amdgcn_mfma_f32_32x32x16_bf16(b1,qr[d0],p1,0,0,0);}
}
typedef __attribute__((address_space(3))) const char* lds_cptr;
typedef short v4i16_t __attribute__((ext_vector_type(4)));
__device__ __forceinline__ void kload8(bf16x8*kf,lds_cptr kp){
  kf[0]=*(const __attribute__((address_space(3))) bf16x8*)(kp);      kf[1]=*(const __attribute__((address_space(3))) bf16x8*)(kp+512);
  kf[2]=*(const __attribute__((address_space(3))) bf16x8*)(kp+2048); kf[3]=*(const __attribute__((address_space(3))) bf16x8*)(kp+2560);
  kf[4]=*(const __attribute__((address_space(3))) bf16x8*)(kp+4096); kf[5]=*(const __attribute__((address_space(3))) bf16x8*)(kp+4608);
  kf[6]=*(const __attribute__((address_space(3))) bf16x8*)(kp+6144); kf[7]=*(const __attribute__((address_space(3))) bf16x8*)(kp+6656);
}
__device__ __forceinline__ void kload2(bf16x8*kf,lds_cptr kp,int j){ kf[2*j]=*(const __attribute__((address_space(3))) bf16x8*)(kp+j*2048); kf[2*j+1]=*(const __attribute__((address_space(3))) bf16x8*)(kp+j*2048+512); }
__device__ __forceinline__ s16x4 vtr(lds_cptr p){ return __builtin_bit_cast(s16x4,__builtin_amdgcn_ds_read_tr16_b64_v4i16((__attribute__((address_space(3))) v4i16_t*)p)); }
__device__ __forceinline__ float rowmax(const f32x16&p0,const f32x16&p1){
  float a=max3f(p0[0],p0[1],p1[0]),b=max3f(p0[2],p0[3],p1[1]);a=max3f(a,p1[2],p1[3]);
  #pragma unroll
  for(int r=4;r<16;r+=4){a=max3f(a,p0[r],p0[r+1]);b=max3f(b,p0[r+2],p0[r+3]);a=max3f(a,p1[r],p1[r+1]);b=max3f(b,p1[r+2],p1[r+3]);}
  const float m=max2f(a,b);
  auto rr=__builtin_amdgcn_permlane32_swap(__float_as_uint(m),__float_as_uint(m),false,false);
  return max2f(__uint_as_float(rr[0]),__uint_as_float(rr[1]));
}
__device__ __forceinline__ void pv(f32x16*o,int vb,bf16x8 pa0,bf16x8 pa1,bf16x8 pa2,bf16x8 pa3){
  #pragma unroll
  for(int d0=0;d0<2;++d0){s16x4 lo[4],hi[4];
    #pragma unroll
    for(int ks=0;ks<4;++ks){
      asm volatile("ds_read_b64_tr_b16 %0,%1 offset:%c2":"=&v"(lo[ks]):"v"(vb),"i"(d0*4096+ks*1024):"memory");
      asm volatile("ds_read_b64_tr_b16 %0,%1 offset:%c2":"=&v"(hi[ks]):"v"(vb),"i"(d0*4096+ks*1024+512):"memory");}
    asm volatile("s_waitcnt lgkmcnt(0)":::"memory");SBAR();
    #define PK(k) (bf16x8){lo[k][0],lo[k][1],lo[k][2],lo[k][3],hi[k][0],hi[k][1],hi[k][2],hi[k][3]}
    o[d0]=__builtin_amdgcn_mfma_f32_32x32x16_bf16(pa0,PK(0),o[d0],0,0,0);
    o[d0]=__builtin_amdgcn_mfma_f32_32x32x16_bf16(pa1,PK(1),o[d0],0,0,0);
    o[d0]=__builtin_amdgcn_mfma_f32_32x32x16_bf16(pa2,PK(2),o[d0],0,0,0);
    o[d0]=__builtin_amdgcn_mfma_f32_32x32x16_bf16(pa3,PK(3),o[d0],0,0,0);
    #undef PK
  }
}

#ifndef ATTN_STORE16
#define ATTN_STORE16(p,v) (*(u32x4*)(p)=(v))
#endif
typedef const __attribute__((address_space(3))) float* lds_cfptr;
template<int THRL> __device__ __forceinline__ void attn_unit(int b,int h,int qb,const bf16*Q,const bf16*__restrict__ K,const bf16*__restrict__ V,const bf16*__restrict__ SG,bf16*MXo,lds_cfptr ck2,char*shm){
  const int tid=threadIdx.x,lane=tid&63,r32=lane&31,hi=lane>>5; const int wid=__builtin_amdgcn_readfirstlane(tid>>6);
  const long rowbase=(long)b*SEQ; const int q0=qb*QB;
  const bf16*Qw=Q+(rowbase+q0+wid*QBLK)*DM+h*D;
  const bf16*Kh=K+rowbase*DM+h*D,*Vh=V+rowbase*DM+h*D;
  const unsigned lds0=(unsigned)(uintptr_t)shm;
  float*wsf=(float*)(shm+LDS_WS)+wid*64;
  const bf16*ksrc=Kh+(long)lane*DM+wid*8;
  const bf16*vsrc=Vh+(long)(16*(wid&3)+(lane>>2))*DM+(wid>>2)*32+(lane&3)*8;
  const unsigned kdst=lds0+LDS_K+wid*1024, vdst=lds0+LDS_V+wid*1024;
  #define DMA_K(t,slot) glds16(ksrc+(long)(t)*KVBLK*DM,(unsigned)__builtin_amdgcn_readfirstlane(kdst+(slot)))
  #define DMA_V(t,slot) glds16(vsrc+(long)(t)*KVBLK*DM,(unsigned)__builtin_amdgcn_readfirstlane(vdst+(slot)))
  const int vb0=(int)(lds0+LDS_V)+((lane>>4)&1)*32+(lane&3)*8+(4*hi+((lane&15)>>2))*64;
  const char*Kbase=shm+LDS_K; bf16x8 kf[8];
  const lds_cptr shm3=(lds_cptr)shm; const lds_cptr kp0=shm3+LDS_K+hi*1024+r32*16; const lds_cptr vp0=shm3+LDS_V+((lane>>4)&1)*32+(lane&3)*8+(4*hi+((lane&15)>>2))*64;
  const int NT=(q0+QB)/KVBLK;
  DMA_K(0,0);DMA_V(0,0);DMA_K(1,SLOTB);
  bf16x8 qr[4];
  #pragma unroll
  for(int d0=0;d0<4;++d0)qr[d0]=*reinterpret_cast<const bf16x8*>(&Qw[(long)r32*DM+d0*16+hi*8]);
  float mhat=0.f,l_reg=0.f;f32x16 o[2];o[0]=f32x16{};o[1]=f32x16{};
  const int qrel=wid*QBLK+r32;
  #define CMASK(P0,P1,t) do{int jb_=(t)-(NT-4); if(jb_>=0)cmask(P0,P1,jb_,qrel,hi);}while(0)
  typedef const __attribute__((address_space(3))) f32x4v* lds_c4ptr;
  #define INITB(P0,P1,t) do{ lds_cfptr cb_=ck2+64*(t)+4*hi; const float nm_=-mhat; _Pragma("unroll") for(int g_=0;g_<4;++g_){ const f32x4v b0_=*(lds_c4ptr)(cb_+8*g_), b1_=*(lds_c4ptr)(cb_+32+8*g_); \
      _Pragma("unroll") for(int j_=0;j_<4;++j_){ P0[4*g_+j_]=nm_-b0_[j_]; P1[4*g_+j_]=nm_-b1_[j_]; } SBAR(); } }while(0)
  bool resc=false;
  #define START(P0,P1) do{ const float rm=rowmax(P0,P1); resc=false; \
    { const float dl=rm; mhat=fadd_s(mhat,dl); \
      _Pragma("unroll") for(int r=0;r<16;++r){P0[r]=fsub_s(P0[r],dl);P1[r]=fsub_s(P1[r],dl);} \
      } \
    _Pragma("unroll") for(int r=0;r<16;++r)P0[r]=__builtin_amdgcn_exp2f(P0[r]); }while(0)
  #define RESC() do{ if(resc){ asm volatile("s_waitcnt lgkmcnt(0)":::"memory"); \
      _Pragma("unroll") for(int d_=0;d_<2;++d_) _Pragma("unroll") for(int r=0;r<16;++r)o[d_][r]*=wsf[crow(r,hi)]; } }while(0)
  f32x16 pA0,pA1,pB0,pB1;
  int sl_prev=0,sl_cur=0,sl_next=SLOTB;
  #define ROT() do{sl_prev=sl_cur;sl_cur=sl_next;sl_next=(sl_next==(NSLOT-1)*SLOTB)?0:sl_next+SLOTB;}while(0)
  DMA_K(2,2*SLOTB);
  WAIT_BAR(3);
  INITB(pA0,pA1,0); qkt(pA0,pA1,Kbase,qr,r32,hi);asm volatile("s_nop 15\n\ts_nop 7":"+v"(pA0),"+v"(pA1));CMASK(pA0,pA1,0);
  START(pA0,pA1);
  _Pragma("unroll") for(int r=0;r<16;++r)pA1[r]=__builtin_amdgcn_exp2f(pA1[r]);
  WAIT_BAR(0);
  DMA_K(3,0);DMA_V(1,SLOTB);
  ROT();
  kload8(kf,kp0+sl_cur);
  WAIT_BAR(2);
  s16x4 vlo[8],vhi[8]; u32x4 pw0,pw1,pw2,pw3;
  #define PKW(P,B) cvtpk_s(P[B],P[B+1])
  #define PAF(k) __builtin_bit_cast(bf16x8,pw##k)
  #define VFR(i) (bf16x8){vlo[i][0],vlo[i][1],vlo[i][2],vlo[i][3],vhi[i][0],vhi[i][1],vhi[i][2],vhi[i][3]}
  #define PIN(x) asm volatile("":"+v"(x))
  #define MX3(a,b,c) __builtin_fmaxf(__builtin_fmaxf((a),(b)),(c))
  #define GAPA(MF,A0,A1,A2,A3,W0,W1,PW) do{ MF; sacc+=A0; sacc+=A1; sacc+=A2; sacc+=A3; PIN(sacc); W0; W1; PIN(PW); SBAR(); }while(0)
  #define EX(v) __builtin_amdgcn_exp2f(v)
  #define GAPB(MF,X,B) do{ MF; X[B]=EX(X[B]); X[B+1]=EX(X[B+1]); X[B+2]=EX(X[B+2]); X[B+3]=EX(X[B+3]); PIN(X); SBAR(); }while(0)
  #define VRD(i) do{ vlo[i]=vtr(vp_+(((i)>>2)*4096+((i)&3)*1024)); vhi[i]=vtr(vp_+(((i)>>2)*4096+((i)&3)*1024+512)); }while(0)
  #define KRD(G,j) do{ if(G){ kload2(kf,kp0+sl_next,j); SBAR(); } }while(0)
  #define STEP(C0,C1,P0,P1,t,GK,GV,GL) do{ SBAR(); INITB(C0,C1,t); SBAR(); \
    const lds_cptr vp_=vp0+sl_prev; \
    VRD(0); SBAR(); float sacc=(P0[0]+P0[1]); \
    GAPA(C0=__builtin_amdgcn_mfma_f32_32x32x16_bf16(kf[0],qr[0],C0,0,0,0), P0[2],P0[3],P0[4],P0[5],     pw0[0]=PKW(P0,0), pw0[1]=PKW(P0,2), pw0); \
    VRD(4); SBAR(); GAPA(C1=__builtin_amdgcn_mfma_f32_32x32x16_bf16(kf[1],qr[0],C1,0,0,0), P0[6],P0[7],P0[8],P0[9],     pw0[2]=PKW(P0,4), pw0[3]=PKW(P0,6), pw0); \
    VRD(1); SBAR(); GAPA(C0=__builtin_amdgcn_mfma_f32_32x32x16_bf16(kf[2],qr[1],C0,0,0,0),   P0[10],P0[11],P0[12],P0[13], pw1[0]=PKW(P0,8), pw1[1]=PKW(P0,10), pw1); \
    VRD(5); SBAR(); GAPA(C1=__builtin_amdgcn_mfma_f32_32x32x16_bf16(kf[3],qr[1],C1,0,0,0),   P0[14],P0[15],P1[0],P1[1],   pw1[2]=PKW(P0,12),pw1[3]=PKW(P0,14), pw1); \
    VRD(2); SBAR(); GAPA(C0=__builtin_amdgcn_mfma_f32_32x32x16_bf16(kf[4],qr[2],C0,0,0,0),   P1[2],P1[3],P1[4],P1[5],     pw2[0]=PKW(P1,0), pw2[1]=PKW(P1,2), pw2); \
    VRD(6); SBAR(); GAPA(C1=__builtin_amdgcn_mfma_f32_32x32x16_bf16(kf[5],qr[2],C1,0,0,0),   P1[6],P1[7],P1[8],P1[9],     pw2[2]=PKW(P1,4), pw2[3]=PKW(P1,6), pw2); \
    VRD(3); SBAR(); GAPA(C0=__builtin_amdgcn_mfma_f32_32x32x16_bf16(kf[6],qr[3],C0,0,0,0),   P1[10],P1[11],P1[12],P1[13], pw3[0]=PKW(P1,8), pw3[1]=PKW(P1,10), pw3); \
    VRD(7); SBAR(); GAPA(C1=__builtin_amdgcn_mfma_f32_32x32x16_bf16(kf[7],qr[3],C1,0,0,0),   P1[14],P1[15],0.f,0.f,       pw3[2]=PKW(P1,12),pw3[3]=PKW(P1,14), pw3); \
    l_reg+=sacc; \
    if(GK){DMA_K((t)+3,sl_cur);} if(GV){DMA_V((t)+1,sl_next);} \
    CMASK(C0,C1,t); \
    { float a=MX3(C0[0],C0[1],C1[0]),b=MX3(C0[2],C0[3],C1[1]); a=MX3(a,C1[2],C1[3]); \
      _Pragma("unroll") for(int r=4;r<16;r+=4){a=MX3(a,C0[r],C0[r+1]);b=MX3(b,C0[r+2],C0[r+3]);a=MX3(a,C1[r],C1[r+1]);b=MX3(b,C1[r+2],C1[r+3]);} \
      float rm=__builtin_fmaxf(a,b); { auto rr=__builtin_amdgcn_permlane32_swap(__float_as_uint(rm),__float_as_uint(rm),false,false); rm=__builtin_fmaxf(__uint_as_float(rr[0]),__uint_as_float(rr[1])); } \
      resc=false; \
      if(__builtin_expect(__any(rm>(float)THRL),0)){ const float dl=__builtin_fmaxf(rm,0.f); mhat+=dl; \
        _Pragma("unroll") for(int r=0;r<16;++r){C0[r]-=dl;C1[r]-=dl;} \
        const float f=__builtin_amdgcn_exp2f(-dl); l_reg*=f; if(hi==0)wsf[r32]=f; resc=true; } } \
    SBAR(); \
    GAPB(o[0]=__builtin_amdgcn_mfma_f32_32x32x16_bf16(PAF(0),VFR(0),o[0],0,0,0), C0,0); \
    GAPB(o[1]=__builtin_amdgcn_mfma_f32_32x32x16_bf16(PAF(0),VFR(4),o[1],0,0,0), C0,4); \
    KRD(GL,0); GAPB(o[0]=__builtin_amdgcn_mfma_f32_32x32x16_bf16(PAF(1),VFR(1),o[0],0,0,0), C0,8); \
    KRD(GL,1); GAPB(o[1]=__builtin_amdgcn_mfma_f32_32x32x16_bf16(PAF(1),VFR(5),o[1],0,0,0), C0,12); \
    KRD(GL,2); GAPB(o[0]=__builtin_amdgcn_mfma_f32_32x32x16_bf16(PAF(2),VFR(2),o[0],0,0,0), C1,0); \
    KRD(GL,3); GAPB(o[1]=__builtin_amdgcn_mfma_f32_32x32x16_bf16(PAF(2),VFR(6),o[1],0,0,0), C1,4); \
    GAPB(o[0]=__builtin_amdgcn_mfma_f32_32x32x16_bf16(PAF(3),VFR(3),o[0],0,0,0), C1,8); \
    GAPB(o[1]=__builtin_amdgcn_mfma_f32_32x32x16_bf16(PAF(3),VFR(7),o[1],0,0,0), C1,12); \
    }while(0)
  int t=1;
  #undef CMASK
  #define CMASK(P0,P1,t) do{}while(0)
  for(;t+5<NT;t+=2){
    STEP(pB0,pB1,pA0,pA1,t,true,true,true);     WAIT_BAR(2); RESC(); ROT();
    STEP(pA0,pA1,pB0,pB1,t+1,true,true,true);   WAIT_BAR(2); RESC(); ROT();
  }
  #undef CMASK
  #define CMASK(P0,P1,t) do{int jb_=(t)-(NT-4); if(jb_>=0)cmask(P0,P1,jb_,qrel,hi);}while(0)
  #define ENDW(tt) do{ if((tt)+3<NT){WAIT_BAR(2);} else if((tt)+2<NT){WAIT_BAR(1);} else {WAIT_BAR(0);} }while(0)
  for(;t+1<NT;t+=2){
    STEP(pB0,pB1,pA0,pA1,t,(t+3<NT),(t+1<NT),(t+1<NT));       ENDW(t);   RESC(); ROT();
    STEP(pA0,pA1,pB0,pB1,t+1,(t+4<NT),(t+2<NT),(t+2<NT));     ENDW(t+1); RESC(); ROT();
  }
  STEP(pB0,pB1,pA0,pA1,NT-1,false,false,false); RESC();
  { float sacc=pB0[0]+pB0[1]; _Pragma("unroll") for(int r=2;r<16;++r)sacc+=pB0[r]; _Pragma("unroll") for(int r=0;r<16;++r)sacc+=pB1[r]; l_reg+=sacc;
    pw0=(u32x4){PKW(pB0,0),PKW(pB0,2),PKW(pB0,4),PKW(pB0,6)};pw1=(u32x4){PKW(pB0,8),PKW(pB0,10),PKW(pB0,12),PKW(pB0,14)};pw2=(u32x4){PKW(pB1,0),PKW(pB1,2),PKW(pB1,4),PKW(pB1,6)};pw3=(u32x4){PKW(pB1,8),PKW(pB1,10),PKW(pB1,12),PKW(pB1,14)};
    SBAR(); pv(o,vb0+sl_cur,PAF(0),PAF(1),PAF(2),PAF(3)); }
  #undef PKW
  #undef PAF
  #undef VFR
  #undef PIN
  #undef MX3
  #undef GAPA
  #undef GAPB
  #undef EX
  #undef VRD
  #undef KRD
  #undef STEP
  #undef ENDW
  {auto rr=__builtin_amdgcn_permlane32_swap(__float_as_uint(l_reg),__float_as_uint(l_reg),false,false);l_reg=__uint_as_float(rr[0])+__uint_as_float(rr[1]);}
  if(hi==0)wsf[32+r32]=l_reg;asm volatile("s_waitcnt lgkmcnt(0)":::"memory");
  float rli[16];
  #pragma unroll
  for(int r=0;r<16;++r)rli[r]=__builtin_amdgcn_rcpf(wsf[32+crow(r,hi)]);
  bf16*Ow=MXo+(rowbase+q0+wid*QBLK)*MXP+h*D; const bf16*Gw=SG+(rowbase+q0+wid*QBLK)*DM+h*D;
  { bf16*stg=(bf16*)(shm+LDS_OST)+wid*2048;
    #pragma unroll
    for(int r=0;r<16;++r){const int orow=crow(r,hi);
      #pragma unroll
      for(int d0=0;d0<2;++d0)stg[orow*64+d0*32+r32]=__float2bfloat16(o[d0][r]*rli[r]);}
    asm volatile("s_waitcnt lgkmcnt(0)":::"memory");
    #pragma unroll
    for(int i=0;i<4;++i){const int row=i*8+(lane>>3),ch=lane&7; u32x4 v=*(const u32x4*)(stg+row*64+ch*8); const u32x4 g=*(const u32x4*)(Gw+(long)row*DM+ch*8);
      _Pragma("unroll") for(int j=0;j<4;++j){ const float a0=__uint_as_float(v[j]<<16)*__uint_as_float(g[j]<<16), a1=__uint_as_float(v[j]&0xffff0000u)*__uint_as_float(g[j]&0xffff0000u); v[j]=cvtpk_s(a0,a1); }
      ATTN_STORE16(Ow+(long)row*MXP+ch*8,v);} }
  asm volatile("s_waitcnt lgkmcnt(0)\n\ts_barrier":::"memory");
  #undef DMA_K
  #undef DMA_V
  #undef CMASK
  #undef START
  #undef RESC
  #undef ROT
}
constexpr int ATTN_LDS_BYTES=LDS_BYTES;
#undef SBAR
#undef WAIT_BAR
}

#define GAS __attribute__((address_space(1)))
#define LAS __attribute__((address_space(3)))
typedef unsigned short bf16;
typedef unsigned v4u __attribute__((ext_vector_type(4)));
typedef float f32x4 __attribute__((ext_vector_type(4)));
typedef short bf16x8 __attribute__((ext_vector_type(8)));
typedef GAS unsigned gu32;
typedef GAS unsigned long long gu64;
#define RLX_AGENT __ATOMIC_RELAXED, __HIP_MEMORY_SCOPE_AGENT
#define LDS_WAIT() asm volatile("s_waitcnt lgkmcnt(0)" ::: "memory")
#define VM_WAIT() asm volatile("s_waitcnt vmcnt(0)" ::: "memory")
__device__ __forceinline__ unsigned long long rt() { return __builtin_amdgcn_s_memrealtime(); }
__device__ __forceinline__ unsigned f2bf(float f) { unsigned u = __builtin_bit_cast(unsigned, f); return (u + 0x7fffu + ((u >> 16) & 1u)) >> 16; }
__device__ __forceinline__ unsigned pk2(float lo, float hi) { return f2bf(lo) | (f2bf(hi) << 16); }

#define XB_TMO      128
#define XB_XCNT(j)  (256  + 64 * (j))
#define XB_XSUB(j)  (1280 + 64 * (j))
#define XB_XGEN(j)  (2304 + 64 * (j))
#define XB_TOP      3328
#define XB_TOPGEN   3392
#define XCD_BAR_WORDS 3456
#define XB_SPIN_CAP (1u << 18)

__device__ __forceinline__ unsigned xb_ld(unsigned* p)              { return __hip_atomic_load(p, __ATOMIC_RELAXED, __HIP_MEMORY_SCOPE_AGENT); }
__device__ __forceinline__ unsigned xb_add(unsigned* p, unsigned v) { return __hip_atomic_fetch_add(p, v, __ATOMIC_RELAXED, __HIP_MEMORY_SCOPE_AGENT); }
__device__ __forceinline__ unsigned xb_xcc_id() { return (unsigned)__builtin_amdgcn_s_getreg((3 << 11) | 20) & 0xFu; }
#define XB_SPIN(cond, bar) do { unsigned _sp = 0; while (cond) { __builtin_amdgcn_s_sleep(1); \
    if ((++_sp & 255u) == 0u) { if (xb_ld(&(bar)[XB_TMO])) break; if (_sp > XB_SPIN_CAP) { atomicAdd(&(bar)[XB_TMO], 1u); break; } } } } while (0)

struct XcdBarrier {
    unsigned* bar; unsigned x;
    volatile LAS unsigned* st;
};

__device__ __forceinline__ XcdBarrier xcd_barrier_post(unsigned* bar, volatile LAS unsigned* st) {
    XcdBarrier b; b.bar = bar; b.x = xb_xcc_id(); b.st = st;
    if (threadIdx.x == 0) (void)xb_add(&bar[XB_XCNT(b.x)], 1u);
    return b;
}
__device__ __forceinline__ void xcd_barrier_complete(unsigned* bar, unsigned x, unsigned& nloc, unsigned& nx) {
    const unsigned G = gridDim.x * gridDim.y * gridDim.z;
    unsigned sum, cnt, mine, sp = 0u;
    for (;;) {
        sum = 0u; cnt = 0u; mine = 0u;
#pragma unroll
        for (unsigned j = 0; j < 16; ++j) { const unsigned c = xb_ld(&bar[XB_XCNT(j)]); sum += c; cnt += (c > 0u) ? 1u : 0u; mine = (j == x) ? c : mine; }
        if (sum == G) break;
        __builtin_amdgcn_s_sleep(1);
        if ((++sp & 255u) == 0u) { if (xb_ld(&bar[XB_TMO])) break; if (sp > XB_SPIN_CAP) { atomicAdd(&bar[XB_TMO], 1u); break; } }
    }
    nloc = mine > 0u ? mine : 1u; nx = cnt > 0u ? cnt : 1u;
}

__device__ __forceinline__ void xcd_barrier(const XcdBarrier& b) {
    asm volatile("s_waitcnt vmcnt(0)" ::: "memory");
    __syncthreads();
    if (threadIdx.x == 0) {
        unsigned* bar = b.bar;
        __builtin_amdgcn_s_waitcnt(0);
        unsigned nloc = b.st[0], nx = b.st[1];
        if (nloc == 0u) { xcd_barrier_complete(bar, b.x, nloc, nx); b.st[0] = nloc; b.st[1] = nx; }
        const unsigned old = xb_add(&bar[XB_XSUB(b.x)], 1u);
        const unsigned gen = old / nloc;
        if (old + 1u == (gen + 1u) * nloc) {
            __builtin_amdgcn_fence(__ATOMIC_RELEASE, "agent");
            asm volatile("s_waitcnt vmcnt(0)" ::: "memory");
            const unsigned og = xb_add(&bar[XB_TOP], 1u);
            const unsigned tg = og / nx;
            if (og + 1u == (tg + 1u) * nx) xb_add(&bar[XB_TOPGEN], 1u);
            else XB_SPIN(xb_ld(&bar[XB_TOPGEN]) == tg, bar);
            __builtin_amdgcn_fence(__ATOMIC_ACQUIRE, "agent");
            xb_add(&bar[XB_XGEN(b.x)], 1u);
            asm volatile("s_waitcnt vmcnt(0)" ::: "memory");
        } else {
            XB_SPIN(xb_ld(&bar[XB_XGEN(b.x)]) == gen, bar);
            __builtin_amdgcn_fence(__ATOMIC_ACQUIRE, "agent");
            asm volatile("s_waitcnt vmcnt(0)" ::: "memory");
        }
    }
    __syncthreads();
}


typedef unsigned u32x4 __attribute__((ext_vector_type(4)));
typedef unsigned u32x2 __attribute__((ext_vector_type(2)));
typedef float f32x2 __attribute__((ext_vector_type(2)));
typedef short s16x4 __attribute__((ext_vector_type(4)));
typedef __bf16 bf16x2_t __attribute__((ext_vector_type(2)));
typedef LAS unsigned char* ldsp;

constexpr int NWAVES = 8;
constexpr int DMODEL = 1024, SEQ = 2048, NBATCH = 8, MP = NBATCH * SEQ, NSAMP = 128, MR = MP + NSAMP, MPAD = 16640;
constexpr int WFOX = 512, WRET = 1024, WMIX = 1536, NIN1 = 5120, EVEN_IN = 5128, GMW = 2048, NIN3 = 6144;
constexpr int NPG = 64;
constexpr float EPS = 1e-6f, LOG2E = 1.4426950408889634f;
constexpr size_t O_Y = 0, O_YS = 16777216, O_KP = O_YS + 131072, O_VP = O_KP + 8388608, O_LFP = O_VP + 8388608, O_RSP = O_LFP + 131072,
                 O_KS = O_RSP + 524288, O_VS = O_KS + 65536, O_LFS = O_VS + 65536, O_RSS = O_LFS + 1024, O_CV = O_RSS + 2097152, O_END = O_CV + 262144;
constexpr size_t MiB = 1u << 20;
constexpr size_t WS_CTL = 0, CTL_ZERO_BYTES = 1 * MiB;
constexpr size_t WS_W1T = 2 * MiB, WS_W2T = 12 * MiB, WS_W3T = 16 * MiB, WS_W4T = 28 * MiB, WS_WSP = 32 * MiB, WS_ROPE = 33 * MiB, WS_RS1 = 34 * MiB,
                 WS_QS32 = 35 * MiB, WS_DEC = 36 * MiB, WS_SSQ = 40 * MiB, WS_VST = 42 * MiB, WS_XB = 48 * MiB, WS_QF = 82 * MiB, WS_KF = 99 * MiB,
                 WS_VF = 116 * MiB, WS_SFG = 133 * MiB, WS_RQ = 150 * MiB, WS_RK = 167 * MiB, WS_RV = 184 * MiB, WS_SRG = 217 * MiB, WS_LT = 250 * MiB,
                 WS_MX = 282 * MiB, WS_X1 = 331 * MiB, WS_X1B = 396 * MiB, WS_UG = 429 * MiB, WS_GV = 494 * MiB, WS_Z = 559 * MiB, WS_END = 624 * MiB;
constexpr size_t DEC_PM = 0, DEC_PL = 8192, DEC_TU = 16384, DEC_PO = 32768;
constexpr int CW_BAR = 4096;
constexpr int RING_BYTES = 131072, MISC_OFF = RING_BYTES, CK_OFF = RING_BYTES + 1024, LDS_BYTES = 147456;
constexpr int ROPE_N = 2052;

__device__ __forceinline__ float bf_lo(unsigned u) { return __uint_as_float(u << 16); }
__device__ __forceinline__ float bf_hi(unsigned u) { return __uint_as_float(u & 0xffff0000u); }
__device__ __forceinline__ float bf1(bf16 v) { return __uint_as_float(((unsigned)v) << 16); }
__device__ __forceinline__ unsigned pkbf(float lo, float hi) { f32x2 v = {lo, hi}; bf16x2_t b = __builtin_convertvector(v, bf16x2_t); return __builtin_bit_cast(unsigned, b); }
__device__ __forceinline__ bf16 f2bf1(float f) { return (bf16)(pkbf(f, 0.f) & 0xffffu); }
__device__ __forceinline__ float wave_sum(float v) {
#pragma unroll
    for (int o = 1; o < 64; o <<= 1) v += __shfl_xor(v, o);
    return v;
}
__device__ __forceinline__ float fast_exp2(float x) { return __builtin_amdgcn_exp2f(x); }
__device__ __forceinline__ float fast_rcp(float x) { return __builtin_amdgcn_rcpf(x); }
__device__ __forceinline__ float silu_f(float x) { return x * fast_rcp(1.f + fast_exp2(-LOG2E * x)); }
__device__ __forceinline__ float gelu_f(float x) { const float t = x + 0.044715f * x * x * x; return x * fast_rcp(1.f + fast_exp2(-2.302208198f * t)); }
__device__ __forceinline__ float ret_lg2(int h) { return log2f(1.0f - exp2f(-5.0f - (float)h)); }

__device__ __forceinline__ bf16x8 frag_row(ldsp img, int pitchB, int row, int k) { return *(const LAS bf16x8*)(img + row * pitchB + k * 2); }
__device__ __forceinline__ bf16x8 frag_tr(ldsp img, int pitchB, int k0, int col0, int lane) {
    const int g = lane >> 4, i = lane & 15, q = i >> 2, p = i & 3;
    ldsp a = img + (k0 + 8 * g + q) * pitchB + (col0 + 4 * p) * 2;
    const s16x4 lo = __builtin_bit_cast(s16x4, __builtin_amdgcn_ds_read_tr16_b64_v4i16((LAS s16x4*)a));
    const s16x4 hi = __builtin_bit_cast(s16x4, __builtin_amdgcn_ds_read_tr16_b64_v4i16((LAS s16x4*)(a + 4 * pitchB)));
    return (bf16x8){lo[0], lo[1], lo[2], lo[3], hi[0], hi[1], hi[2], hi[3]};
}
#define MFMA16(a, b, c) __builtin_amdgcn_mfma_f32_16x16x32_bf16((a), (b), (c), 0, 0, 0)

struct Args { const float* in[20]; float* out; unsigned char* ws; int ph_lo, ph_hi; };
#define WSP(T, off) ((T*)(A.ws + (off)))

struct EpiEven {
    static constexpr bool PERM = true, AFTER_DRAIN = false;
    const float* rs; bf16 *QF, *KF, *VF, *SFG, *RQ, *RK, *RV, *SRG; float* out; float* qs32; const float *gq, *gk, *ropec, *ropes;
    __device__ __forceinline__ void operator()(const pg8::f32x4 (&acc)[2][2][4][2], const pg8::Unit& u, int wr, int wc, int fr, int fq) const {
        const int pn = u.pn;
        const int kind = pn < 12 ? (pn >> 1) : (pn < 16 ? 6 : 7);
        const int first = kind < 6 ? kind * 2 : (kind == 6 ? 12 : 16);
        const int colh = (pn - first) * 256 + 64 * wc;
        bf16* dst = kind == 0 ? QF : kind == 1 ? KF : kind == 2 ? VF : kind == 3 ? SFG : kind == 4 ? RQ : kind == 5 ? RK : kind == 6 ? RV : SRG;
        const int ldd = kind < 6 ? 512 : 1024;
        f32x4 gv[2][2];
        if (kind <= 1) { const float* g = kind == 0 ? gq : gk;
#pragma unroll
            for (int bj = 0; bj < 2; ++bj)
#pragma unroll
                for (int n = 0; n < 2; ++n) gv[bj][n] = *(const f32x4*)(g + 32 * bj + 8 * fq + 4 * n); }
#pragma unroll
        for (int ai = 0; ai < 2; ++ai) {
            if (u.pm * 256 + ai * 128 >= MR) continue;
#pragma unroll
            for (int m = 0; m < 4; ++m) {
                const int row = u.pm * 256 + ai * 128 + wr * 64 + m * 16 + fr;
                const float r = rs[row];
                f32x4 v[2][2];
#pragma unroll
                for (int bj = 0; bj < 2; ++bj)
#pragma unroll
                    for (int n = 0; n < 2; ++n) v[bj][n] = acc[ai][bj][m][n] * r;
                if (kind <= 1) {
                    float ss = 0.f;
#pragma unroll
                    for (int bj = 0; bj < 2; ++bj)
#pragma unroll
                        for (int n = 0; n < 2; ++n) ss += (v[bj][n][0] * v[bj][n][0] + v[bj][n][1] * v[bj][n][1]) + (v[bj][n][2] * v[bj][n][2] + v[bj][n][3] * v[bj][n][3]);
                    ss += __shfl_xor(ss, 16); ss += __shfl_xor(ss, 32);
                    float sc = 1.0f / sqrtf(ss * (1.0f / 64.0f) + EPS);
                    if (kind == 0) sc *= attn_body::C2;
#pragma unroll
                    for (int bj = 0; bj < 2; ++bj)
#pragma unroll
                        for (int n = 0; n < 2; ++n) v[bj][n] = v[bj][n] * sc * gv[bj][n];
                } else if (kind == 3 || kind == 7) {
#pragma unroll
                    for (int bj = 0; bj < 2; ++bj)
#pragma unroll
                        for (int n = 0; n < 2; ++n)
#pragma unroll
                            for (int e = 0; e < 4; ++e) v[bj][n][e] = silu_f(v[bj][n][e]);
                } else if (kind == 4 || kind == 5) {
                    const int pidx = row < MP ? (row & (SEQ - 1)) : SEQ + ((row - MP) & 3);
                    const float ks = kind == 5 ? 0.125f : 1.0f;
#pragma unroll
                    for (int n = 0; n < 2; ++n) {
                        const f32x4 c = *(const f32x4*)(ropec + pidx * 32 + 8 * fq + 4 * n), s = *(const f32x4*)(ropes + pidx * 32 + 8 * fq + 4 * n);
                        const f32x4 x1 = v[0][n], x2 = v[1][n];
                        v[0][n] = (x1 * c - x2 * s) * ks; v[1][n] = (x1 * s + x2 * c) * ks;
                    }
                }
                bf16* drow = dst + (size_t)row * ldd + colh + 8 * fq;
#pragma unroll
                for (int bj = 0; bj < 2; ++bj) {
                    u32x4 w; w.x = pkbf(v[bj][0][0], v[bj][0][1]); w.y = pkbf(v[bj][0][2], v[bj][0][3]); w.z = pkbf(v[bj][1][0], v[bj][1][1]); w.w = pkbf(v[bj][1][2], v[bj][1][3]);
                    *(u32x4*)(drow + 32 * bj) = w;
                }
                if (kind == 1 || kind == 2) {
                    float* o = row < MP ? out + (kind == 1 ? O_KP : O_VP) + (size_t)row * 512 : out + (kind == 1 ? O_KS : O_VS) + (size_t)(row - MP) * 512;
                    o += colh + 8 * fq;
#pragma unroll
                    for (int bj = 0; bj < 2; ++bj)
#pragma unroll
                        for (int n = 0; n < 2; ++n) *(f32x4*)(o + 32 * bj + 4 * n) = v[bj][n];
                }
                if (kind == 0 && row >= MP) {
                    float* o = qs32 + (size_t)(row - MP) * 512 + colh + 8 * fq;
#pragma unroll
                    for (int bj = 0; bj < 2; ++bj)
#pragma unroll
                        for (int n = 0; n < 2; ++n) *(f32x4*)(o + 32 * bj + 4 * n) = v[bj][n];
                }
            }
        }
    }
};
struct EpiRes1 {
    static constexpr bool PERM = true, AFTER_DRAIN = false;
    const float *xp, *xs; float* X1; bf16* X1B; float* ssq;
    __device__ __forceinline__ void operator()(const pg8::f32x4 (&acc)[2][2][4][2], const pg8::Unit& u, int wr, int wc, int fr, int fq) const {
#pragma unroll
        for (int ai = 0; ai < 2; ++ai) {
            if (u.pm * 256 + ai * 128 >= MR) continue;
#pragma unroll
            for (int m = 0; m < 4; ++m) {
                const int row = u.pm * 256 + ai * 128 + wr * 64 + m * 16 + fr;
                const int col0 = u.pn * 256 + wc * 32 + 8 * fq;
                const float* xr = (row < MP ? xp + (size_t)row * DMODEL : xs + (size_t)(row - MP) * DMODEL) + col0;
                float ss = 0.f;
#pragma unroll
                for (int bj = 0; bj < 2; ++bj) {
                    const f32x4 a = *(const f32x4*)(xr + 128 * bj) + acc[ai][bj][m][0], b = *(const f32x4*)(xr + 128 * bj + 4) + acc[ai][bj][m][1];
                    ss += (a[0] * a[0] + a[1] * a[1]) + (a[2] * a[2] + a[3] * a[3]) + (b[0] * b[0] + b[1] * b[1]) + (b[2] * b[2] + b[3] * b[3]);
                    float* o = X1 + (size_t)row * DMODEL + col0 + 128 * bj; *(f32x4*)o = a; *(f32x4*)(o + 4) = b;
                    u32x4 w; w.x = pkbf(a[0], a[1]); w.y = pkbf(a[2], a[3]); w.z = pkbf(b[0], b[1]); w.w = pkbf(b[2], b[3]);
                    *(u32x4*)(X1B + (size_t)row * DMODEL + col0 + 128 * bj) = w;
                }
                ss += __shfl_xor(ss, 16); ss += __shfl_xor(ss, 32);
                if (fq == 0) ssq[(size_t)row * 16 + u.pn * 4 + wc] = ss;
            }
        }
    }
};
struct EpiOdd {
    static constexpr bool PERM = true, AFTER_DRAIN = false;
    const float* ssq; bf16 *UG, *GV; f32x2* vst;
    __device__ __forceinline__ void operator()(const pg8::f32x4 (&acc)[2][2][4][2], const pg8::Unit& u, int wr, int wc, int fr, int fq) const {
#pragma unroll
        for (int ai = 0; ai < 2; ++ai) {
            if (u.pm * 256 + ai * 128 >= MR) continue;
#pragma unroll
            for (int m = 0; m < 4; ++m) {
                const int row = u.pm * 256 + ai * 128 + wr * 64 + m * 16 + fr;
                const f32x4* sp = (const f32x4*)(ssq + (size_t)row * 16);
                const f32x4 s0 = sp[0], s1 = sp[1], s2 = sp[2], s3 = sp[3];
                const float tot = ((s0[0] + s0[1]) + (s0[2] + s0[3])) + ((s1[0] + s1[1]) + (s1[2] + s1[3])) + ((s2[0] + s2[1]) + (s2[2] + s2[3])) + ((s3[0] + s3[1]) + (s3[2] + s3[3]));
                const float r = 1.0f / sqrtf(tot * (1.0f / DMODEL) + EPS);
                if (u.pn < 16) {
                    u32x4 w; unsigned* wp = (unsigned*)&w;
#pragma unroll
                    for (int n = 0; n < 2; ++n) {
                        float z[4];
#pragma unroll
                        for (int e = 0; e < 4; ++e) z[e] = gelu_f(acc[ai][0][m][n][e] * r) * silu_f(acc[ai][1][m][n][e] * r);
                        wp[2 * n] = pkbf(z[0], z[1]); wp[2 * n + 1] = pkbf(z[2], z[3]);
                    }
                    *(u32x4*)(UG + (size_t)row * GMW + u.pn * 128 + wc * 32 + 8 * fq) = w;
                } else {
                    float s = 0.f, q = 0.f;
#pragma unroll
                    for (int bj = 0; bj < 2; ++bj) {
                        u32x4 w; unsigned* wp = (unsigned*)&w;
#pragma unroll
                        for (int n = 0; n < 2; ++n) {
                            float z[4];
#pragma unroll
                            for (int e = 0; e < 4; ++e) { z[e] = gelu_f(acc[ai][bj][m][n][e] * r); s += z[e]; q += z[e] * z[e]; }
                            wp[2 * n] = pkbf(z[0], z[1]); wp[2 * n + 1] = pkbf(z[2], z[3]);
                        }
                        *(u32x4*)(GV + (size_t)row * GMW + (u.pn - 16) * 256 + 128 * bj + wc * 32 + 8 * fq) = w;
                    }
                    s += __shfl_xor(s, 16); s += __shfl_xor(s, 32); q += __shfl_xor(q, 16); q += __shfl_xor(q, 32);
                    if (fq == 0) vst[(size_t)row * 32 + (u.pn - 16) * 4 + wc] = (f32x2){s, q};
                }
            }
        }
    }
};
struct EpiRes2 {
    static constexpr bool PERM = true, AFTER_DRAIN = false;
    const float* X1; float* out;
    __device__ __forceinline__ void operator()(const pg8::f32x4 (&acc)[2][2][4][2], const pg8::Unit& u, int wr, int wc, int fr, int fq) const {
#pragma unroll
        for (int ai = 0; ai < 2; ++ai) {
            if (u.pm * 256 + ai * 128 >= MR) continue;
#pragma unroll
            for (int m = 0; m < 4; ++m) {
                const int row = u.pm * 256 + ai * 128 + wr * 64 + m * 16 + fr;
                const int col0 = u.pn * 256 + wc * 32 + 8 * fq;
                const float* xr = X1 + (size_t)row * DMODEL + col0;
                float* o = (row < MP ? out + O_Y + (size_t)row * DMODEL : out + O_YS + (size_t)(row - MP) * DMODEL) + col0;
#pragma unroll
                for (int bj = 0; bj < 2; ++bj) {
                    *(f32x4*)(o + 128 * bj) = *(const f32x4*)(xr + 128 * bj) + acc[ai][bj][m][0];
                    *(f32x4*)(o + 128 * bj + 4) = *(const f32x4*)(xr + 128 * bj + 4) + acc[ai][bj][m][1];
                }
            }
        }
    }
};

__device__ __forceinline__ void p0_transpose_item(const float* W, int ldw, int srccol0, int k0, const float* gain, bf16* WT, int K, int dstrow0, LAS float* scr, int lane) {
#pragma unroll 8
    for (int i = 0; i < 32; ++i) { const int kk = 2 * i + (lane >> 5); float v = W[(size_t)(k0 + kk) * ldw + srccol0 + (lane & 31)]; if (gain) v *= gain[k0 + kk]; scr[kk * 33 + (lane & 31)] = v; }
    LDS_WAIT(); asm volatile("" ::: "memory");
    const int c = lane & 7;
#pragma unroll
    for (int j = 0; j < 4; ++j) { const int n = (lane >> 3) + 8 * j; const LAS float* s = scr + (8 * c) * 33 + n;
        u32x4 o; o.x = pkbf(s[0 * 33], s[1 * 33]); o.y = pkbf(s[2 * 33], s[3 * 33]); o.z = pkbf(s[4 * 33], s[5 * 33]); o.w = pkbf(s[6 * 33], s[7 * 33]);
        *(u32x4*)(WT + (size_t)(dstrow0 + n) * K + k0 + 8 * c) = o; }
    LDS_WAIT(); asm volatile("" ::: "memory");
}
__device__ __forceinline__ int w1_srccol(int P) {
    const int tile = P >> 8, p = P & 255, bj = p >> 7, wc = (p & 127) >> 5, l = tile * 256 + 64 * wc + 32 * bj;
    return l + (l >= 1536 ? 8 : 0);
}
__device__ __forceinline__ int w3_srccol(int P) {
    const int tile = P >> 8, p = P & 255;
    if (tile < 16) return p < 128 ? 128 * tile + p : 4096 + 128 * tile + (p - 128);
    return 2048 + 256 * (tile - 16) + p;
}
__device__ __forceinline__ void p0_prologue(const Args& A, ldsp lds, int vcu, int G, int tid, int wave, int lane) {
    LAS float* scr = (LAS float*)(lds + wave * 8704);
    LAS float* wff = (LAS float*)(lds + 73728);
    const float* w1 = A.in[8]; const float* g1 = A.in[7];
    for (int i = tid; i < 8192; i += NWAVES * 64) { const int k = i >> 3, j = i & 7; wff[i] = w1[(size_t)k * EVEN_IN + 1536 + j] * g1[k]; }
    __syncthreads();
    const int gw = vcu * NWAVES + wave, NGW = G * NWAVES;
    constexpr int I_W1 = 16 * 160, I_W2 = 24 * 32, I_W3 = 16 * 192, I_W4 = 32 * 32, I_ROW = MPAD, I_ROPE = ROPE_N / 2, I_WSP = 1024;
    constexpr int NITEMS = I_W1 + I_W2 + I_W3 + I_W4 + I_ROW + I_ROPE + I_WSP;
    for (int it = gw; it < NITEMS; it += NGW) {
        int r = it;
        if (r < I_ROW) {
            bf16* xb = WSP(bf16, WS_XB) + (size_t)r * DMODEL; float* rs1 = WSP(float, WS_RS1);
            if (r >= MR) { u32x4 z = {0u, 0u, 0u, 0u}; *(u32x4*)(xb + lane * 16) = z; *(u32x4*)(xb + lane * 16 + 8) = z; if (lane == 0) rs1[r] = 0.f; continue; }
            const float* src = r < MP ? A.in[0] + (size_t)r * DMODEL : A.in[1] + (size_t)(r - MP) * DMODEL;
            float ss = 0.f, dt[8];
#pragma unroll
            for (int j = 0; j < 8; ++j) dt[j] = 0.f;
#pragma unroll
            for (int j = 0; j < 8; ++j) {
                const int k = 2 * lane + 128 * j;
                const f32x2 v = *(const f32x2*)(src + k);
                ss += v.x * v.x + v.y * v.y;
                const LAS f32x4* wp = (const LAS f32x4*)(wff + k * 8);
                const f32x4 a0 = wp[0], a1 = wp[1], b0 = wp[2], b1 = wp[3];
                dt[0] += v.x * a0[0] + v.y * b0[0]; dt[1] += v.x * a0[1] + v.y * b0[1]; dt[2] += v.x * a0[2] + v.y * b0[2]; dt[3] += v.x * a0[3] + v.y * b0[3];
                dt[4] += v.x * a1[0] + v.y * b1[0]; dt[5] += v.x * a1[1] + v.y * b1[1]; dt[6] += v.x * a1[2] + v.y * b1[2]; dt[7] += v.x * a1[3] + v.y * b1[3];
                *(unsigned*)(xb + k) = pkbf(v.x, v.y);
            }
            ss = wave_sum(ss);
#pragma unroll
            for (int j = 0; j < 8; ++j) dt[j] = wave_sum(dt[j]);
            const float rs = 1.0f / sqrtf(ss * (1.0f / DMODEL) + EPS);
            if (lane == 0) rs1[r] = rs;
            if (lane < 8) {
                float d = dt[0];
#pragma unroll
                for (int j = 1; j < 8; ++j) d = lane == j ? dt[j] : d;
                const float z = rs * d + A.in[9][lane];
                const float lf = fminf(z, 0.f) - log1pf(expf(-fabsf(z)));
                float* o = r < MP ? A.out + O_LFP + (size_t)r * 8 : A.out + O_LFS + (size_t)(r - MP) * 8;
                o[lane] = lf;
            }
            continue;
        }
        r -= I_ROW;
        if (r < I_W1) { const int kb = r / 160, nb = r % 160; p0_transpose_item(w1, EVEN_IN, w1_srccol(32 * nb), 64 * kb, g1, WSP(bf16, WS_W1T), 1024, 32 * nb, scr, lane); continue; }
        r -= I_W1;
        if (r < I_W2) { const int kb = r / 32, nb = r % 32; p0_transpose_item(A.in[13], 1024, 32 * nb, 64 * kb, nullptr, WSP(bf16, WS_W2T), 1536, 32 * nb, scr, lane); continue; }
        r -= I_W2;
        if (r < I_W3) { const int kb = r / 192, nb = r % 192; p0_transpose_item(A.in[15], NIN3, w3_srccol(32 * nb), 64 * kb, A.in[14], WSP(bf16, WS_W3T), 1024, 32 * nb, scr, lane); continue; }
        r -= I_W3;
        if (r < I_W4) { const int kb = r / 32, nb = r % 32; p0_transpose_item(A.in[19], 1024, 32 * nb, 64 * kb, nullptr, WSP(bf16, WS_W4T), 2048, 32 * nb, scr, lane); continue; }
        r -= I_W4;
        if (r < I_ROPE) {
            const int p = 2 * r + (lane >> 5), j = lane & 31;
            const int pos = p < SEQ ? p : 8192 + (p - SEQ);
            const float inv = powf(10000.0f, -(float)j * (1.0f / 32.0f));
            const float ang = (float)pos * inv;
            const double rev = (double)ang * 0.15915494309189535;
            const float fr = (float)(rev - rint(rev));
            float* rc = WSP(float, WS_ROPE); float* rsn = rc + ROPE_N * 32;
            rc[p * 32 + j] = __builtin_amdgcn_cosf(fr); rsn[p * 32 + j] = __builtin_amdgcn_sinf(fr);
            continue;
        }
        r -= I_ROPE;
        {
            const int t = r & 127; const float* w = A.in[17] + (size_t)r * 128; bf16* o = WSP(bf16, WS_WSP) + (size_t)r * 128;
            o[lane] = f2bf1(lane <= t ? w[lane] : 0.f); o[lane + 64] = f2bf1(lane + 64 <= t ? w[lane + 64] : 0.f);
        }
    }
}

__device__ __forceinline__ void ret_pass_a(const Args& A, ldsp lds, int bh, int Gq, int tid, int wave, int lane) {
    const int b = bh >> 3, h = bh & 7;
    ldsp Kimg = lds, Vimg = lds + 18432;
    const float lg = ret_lg2(h), g128 = exp2f(lg * 128.f);
    const bf16* RK = WSP(bf16, WS_RK); const bf16* RV = WSP(bf16, WS_RV); float* LT = WSP(float, WS_LT);
    f32x4 acc[4];
#pragma unroll
    for (int i = 0; i < 4; ++i) acc[i] = (f32x4){0.f, 0.f, 0.f, 0.f};
    for (int c = 0; c < 4; ++c) {
        const int n = 4 * Gq + c; const size_t row0 = (size_t)b * SEQ + n * 128;
#pragma unroll
        for (int j = 0; j < 2; ++j) { const int idx = tid + 512 * j, pos = idx >> 3, ch = idx & 7;
            u32x4 kv = *(const u32x4*)(RK + (row0 + pos) * 512 + h * 64 + ch * 8); const float f = exp2f(lg * (float)(127 - pos));
            unsigned* kp = (unsigned*)&kv;
#pragma unroll
            for (int e = 0; e < 4; ++e) kp[e] = pkbf(bf_lo(kp[e]) * f, bf_hi(kp[e]) * f);
            *(LAS u32x4*)(Kimg + pos * 144 + ch * 16) = kv; }
#pragma unroll
        for (int j = 0; j < 4; ++j) { const int idx = tid + 512 * j, pos = idx >> 4, ch = idx & 15;
            *(LAS u32x4*)(Vimg + pos * 272 + ch * 16) = *(const u32x4*)(RV + (row0 + pos) * 1024 + h * 128 + ch * 8); }
        __syncthreads();
        if (c > 0) {
#pragma unroll
            for (int i = 0; i < 4; ++i) acc[i] = acc[i] * g128;
        }
#pragma unroll
        for (int ks = 0; ks < 4; ++ks) {
            const bf16x8 a = frag_tr(Vimg, 272, 32 * ks, 16 * wave, lane);
#pragma unroll
            for (int nt = 0; nt < 4; ++nt) { const bf16x8 bb = frag_tr(Kimg, 144, 32 * ks, 16 * nt, lane); acc[nt] = MFMA16(a, bb, acc[nt]); }
        }
        float* lt = LT + ((size_t)(bh * 16 + n) * 128 + 16 * wave + 4 * (lane >> 4)) * 64 + (lane & 15);
#pragma unroll
        for (int nt = 0; nt < 4; ++nt)
#pragma unroll
            for (int i = 0; i < 4; ++i) lt[i * 64 + 16 * nt] = acc[nt][i];
        __syncthreads();
    }
}
__device__ __forceinline__ void decode_unit(const Args& A, ldsp lds, int b, int g, int tid, int wave, int lane) {
    LAS float* Dl = (LAS float*)lds;
    LAS float* Tl = (LAS float*)(lds + 32768);
    LAS float* PMl = (LAS float*)(lds + 33280);
    LAS float* PLl = (LAS float*)(lds + 34304);
    LAS float* POl = (LAS float*)(lds + 36864);
    const int* pt = (const int*)A.in[6];
    const size_t page = (size_t)pt[b * NPG + 8 * g + wave];
    {
        const float* lfp = A.in[4] + page * 1024; const int h = lane & 7, pgp = lane >> 3;
        float v[16], e[16], run = 0.f;
#pragma unroll
        for (int j = 0; j < 16; ++j) v[j] = lfp[(16 * pgp + j) * 8 + h] * LOG2E;
#pragma unroll
        for (int j = 15; j >= 0; --j) { e[j] = run; run += v[j]; }
        float x = run;
#pragma unroll
        for (int s = 8; s < 64; s <<= 1) { const float y = __shfl_down(x, s); if (lane + s < 64) x += y; }
        const float excl = x - run;
#pragma unroll
        for (int j = 0; j < 16; ++j) Dl[wave * 1024 + (16 * pgp + j) * 8 + h] = e[j] + excl;
        if (pgp == 0) Tl[wave * 8 + h] = x;
    }
    __syncthreads();
    const int hl = lane >> 3, dl = (lane & 7) * 8;
    float later = 0.f;
    for (int w2 = wave + 1; w2 < 8; ++w2) later += Tl[w2 * 8 + hl];
    float* dec = WSP(float, WS_DEC);
    if (wave == 0 && lane < 8) { float t = 0.f; for (int w2 = 0; w2 < 8; ++w2) t += Tl[w2 * 8 + lane]; dec[DEC_TU + (b * 8 + g) * 8 + lane] = t; }
    const float* qs = WSP(float, WS_QS32);
    float q[4][8], o[4][8], mx[4], ls[4];
#pragma unroll
    for (int i = 0; i < 4; ++i) { const f32x4 a = *(const f32x4*)(qs + (4 * b + i) * 512 + hl * 64 + dl), c = *(const f32x4*)(qs + (4 * b + i) * 512 + hl * 64 + dl + 4);
        q[i][0] = a[0]; q[i][1] = a[1]; q[i][2] = a[2]; q[i][3] = a[3]; q[i][4] = c[0]; q[i][5] = c[1]; q[i][6] = c[2]; q[i][7] = c[3];
#pragma unroll
        for (int c2 = 0; c2 < 8; ++c2) o[i][c2] = 0.f;
        mx[i] = -1e30f; ls[i] = 0.f; }
    const float* kp = A.in[2] + page * 65536 + lane * 8; const float* vp = A.in[3] + page * 65536 + lane * 8;
    const LAS float* dw = Dl + wave * 1024 + hl;
#pragma unroll 1
    for (int p0 = 0; p0 < 128; p0 += 4) {
        float kk[4][8], vv[4][8];
#pragma unroll
        for (int jj = 0; jj < 4; ++jj) { const f32x4 a = *(const f32x4*)(kp + (p0 + jj) * 512), c = *(const f32x4*)(kp + (p0 + jj) * 512 + 4);
            kk[jj][0] = a[0]; kk[jj][1] = a[1]; kk[jj][2] = a[2]; kk[jj][3] = a[3]; kk[jj][4] = c[0]; kk[jj][5] = c[1]; kk[jj][6] = c[2]; kk[jj][7] = c[3]; }
#pragma unroll
        for (int jj = 0; jj < 4; ++jj) { const f32x4 a = *(const f32x4*)(vp + (p0 + jj) * 512), c = *(const f32x4*)(vp + (p0 + jj) * 512 + 4);
            vv[jj][0] = a[0]; vv[jj][1] = a[1]; vv[jj][2] = a[2]; vv[jj][3] = a[3]; vv[jj][4] = c[0]; vv[jj][5] = c[1]; vv[jj][6] = c[2]; vv[jj][7] = c[3]; }
        float x[4][4];
#pragma unroll
        for (int jj = 0; jj < 4; ++jj) {
            const float bias = dw[(p0 + jj) * 8] + later;
#pragma unroll
            for (int i = 0; i < 4; ++i) {
                float s = 0.f;
#pragma unroll
                for (int c = 0; c < 8; ++c) s += q[i][c] * kk[jj][c];
                s += __shfl_xor(s, 1); s += __shfl_xor(s, 2); s += __shfl_xor(s, 4);
                x[jj][i] = s + bias;
            }
        }
#pragma unroll
        for (int i = 0; i < 4; ++i) {
            const float gm = fmaxf(fmaxf(x[0][i], x[1][i]), fmaxf(x[2][i], x[3][i]));
            const float mn = fmaxf(mx[i], gm), sc = fast_exp2(mx[i] - mn);
            const float p0e = fast_exp2(x[0][i] - mn), p1e = fast_exp2(x[1][i] - mn), p2e = fast_exp2(x[2][i] - mn), p3e = fast_exp2(x[3][i] - mn);
            ls[i] = ls[i] * sc + ((p0e + p1e) + (p2e + p3e)); mx[i] = mn;
#pragma unroll
            for (int c = 0; c < 8; ++c) o[i][c] = o[i][c] * sc + ((p0e * vv[0][c] + p1e * vv[1][c]) + (p2e * vv[2][c] + p3e * vv[3][c]));
        }
    }
#pragma unroll
    for (int i = 0; i < 4; ++i) {
        if ((lane & 7) == 0) { PMl[(wave * 4 + i) * 8 + hl] = mx[i]; PLl[(wave * 4 + i) * 8 + hl] = ls[i]; }
        LAS float* po = POl + (wave * 4 + i) * 512 + hl * 64 + dl;
        *(LAS f32x4*)po = (f32x4){o[i][0], o[i][1], o[i][2], o[i][3]}; *(LAS f32x4*)(po + 4) = (f32x4){o[i][4], o[i][5], o[i][6], o[i][7]};
    }
    __syncthreads();
    {
        const int i = tid >> 7, c4 = (tid & 127) * 4, h = c4 >> 6;
        float M = -1e30f;
#pragma unroll
        for (int w2 = 0; w2 < 8; ++w2) M = fmaxf(M, PMl[(w2 * 4 + i) * 8 + h]);
        float L = 0.f; f32x4 O = {0.f, 0.f, 0.f, 0.f};
#pragma unroll
        for (int w2 = 0; w2 < 8; ++w2) { const float f = fast_exp2(PMl[(w2 * 4 + i) * 8 + h] - M); L += PLl[(w2 * 4 + i) * 8 + h] * f; O += *(const LAS f32x4*)(POl + (w2 * 4 + i) * 512 + c4) * f; }
        const size_t ui = (size_t)(b * 8 + g) * 4 + i;
        *(f32x4*)(dec + DEC_PO + ui * 512 + c4) = O;
        if ((c4 & 63) == 0) { dec[DEC_PM + ui * 8 + h] = M; dec[DEC_PL + ui * 8 + h] = L; }
    }
    __syncthreads();
}
__device__ __forceinline__ void ret_sample_unit(const Args& A, ldsp lds, int bh, int tid, int wave, int lane) {
    const int b = bh >> 3, h = bh & 7;
    LAS float* qs = (LAS float*)lds; LAS float* ks = qs + 256; LAS float* vs = qs + 512; LAS float* sc = qs + 1024; LAS float* red = qs + 1088; LAS float* ob = red + 2048;
    const bf16* RQ = WSP(bf16, WS_RQ); const bf16* RK = WSP(bf16, WS_RK); const bf16* RV = WSP(bf16, WS_RV); const bf16* SRG = WSP(bf16, WS_SRG); bf16* MX = WSP(bf16, WS_MX);
    const float lg = ret_lg2(h);
    if (tid < 256) { const int l = tid >> 6, d = tid & 63; qs[tid] = bf1(RQ[(size_t)(MP + 4 * b + l) * 512 + h * 64 + d]); ks[tid] = bf1(RK[(size_t)(MP + 4 * b + l) * 512 + h * 64 + d]); }
    { const int l = tid >> 7, e = tid & 127; vs[tid] = bf1(RV[(size_t)(MP + 4 * b + l) * 1024 + h * 128 + e]); }
    __syncthreads();
    if (tid < 16) { const int l = tid >> 2, m = tid & 3; float d = 0.f; for (int c = 0; c < 64; ++c) d += qs[l * 64 + c] * ks[m * 64 + c]; sc[tid] = m <= l ? d * exp2f(lg * (float)(l - m)) : 0.f; }
    {
        const int e = tid & 127, dg = tid >> 7;
        const float g4 = exp2f(lg * 4.f), gm0 = exp2f(lg * 3.f), gm1 = exp2f(lg * 2.f), gm2 = exp2f(lg), gm3 = 1.f;
        const float v0 = vs[e] * gm0, v1 = vs[128 + e] * gm1, v2 = vs[256 + e] * gm2, v3 = vs[384 + e] * gm3;
        float c0 = 0.f, c1 = 0.f, c2 = 0.f, c3 = 0.f;
        const float* st = A.in[5] + ((size_t)bh * 64) * 128 + e; float* so = A.out + O_RSS + ((size_t)bh * 64) * 128 + e;
#pragma unroll 4
        for (int dd = 0; dd < 16; ++dd) { const int d = dg * 16 + dd; const float S = st[(size_t)d * 128];
            c0 += qs[d] * S; c1 += qs[64 + d] * S; c2 += qs[128 + d] * S; c3 += qs[192 + d] * S;
            so[(size_t)d * 128] = g4 * S + ((ks[d] * v0 + ks[64 + d] * v1) + (ks[128 + d] * v2 + ks[192 + d] * v3)); }
        red[(dg * 4 + 0) * 128 + e] = c0; red[(dg * 4 + 1) * 128 + e] = c1; red[(dg * 4 + 2) * 128 + e] = c2; red[(dg * 4 + 3) * 128 + e] = c3;
    }
    __syncthreads();
    if (tid < 128) { const int e = tid;
#pragma unroll
        for (int l = 0; l < 4; ++l) { float o = exp2f(lg * (float)(l + 1)) * ((red[(0 + l) * 128 + e] + red[(4 + l) * 128 + e]) + (red[(8 + l) * 128 + e] + red[(12 + l) * 128 + e]));
#pragma unroll
            for (int m = 0; m < 4; ++m) o += sc[l * 4 + m] * vs[m * 128 + e];
            ob[l * 128 + e] = o; } }
    __syncthreads();
    if (wave < 4) { const int l = wave; const float x0 = ob[l * 128 + lane], x1 = ob[l * 128 + 64 + lane];
        const float mean = wave_sum(x0 + x1) * (1.f / 128.f), d0 = x0 - mean, d1 = x1 - mean;
        const float rstd = 1.0f / sqrtf(wave_sum(d0 * d0 + d1 * d1) * (1.f / 128.f) + EPS);
        const float* gr = A.in[12] + h * 128; const size_t row = MP + 4 * b + l;
        MX[row * WMIX + 512 + h * 128 + lane] = f2bf1(d0 * rstd * gr[lane] * bf1(SRG[row * 1024 + h * 128 + lane]));
        MX[row * WMIX + 512 + h * 128 + 64 + lane] = f2bf1(d1 * rstd * gr[64 + lane] * bf1(SRG[row * 1024 + h * 128 + 64 + lane])); }
    __syncthreads();
}

__device__ __forceinline__ void ret_state_sum(const float* LTbh, int k, float lg, int e, int d0, f32x4 (&s)[4]) {
#pragma unroll
    for (int j = 0; j < 4; ++j) s[j] = *(const f32x4*)(LTbh + ((size_t)k * 128 + e) * 64 + d0 + 4 * j);
    for (int Gp = 0; Gp < (k >> 2); ++Gp) { const int jm = 4 * Gp + 3; const float cf = exp2f(lg * 128.f * (float)(k - jm));
#pragma unroll
        for (int j = 0; j < 4; ++j) s[j] += *(const f32x4*)(LTbh + ((size_t)jm * 128 + e) * 64 + d0 + 4 * j) * cf; }
}
__device__ __forceinline__ void ret_pass_c(const Args& A, ldsp lds, int bh, int n, int tid, int wave, int lane) {
    const int b = bh >> 3, h = bh & 7;
    ldsp AP = lds, Kimg = lds + 51200, Vimg = lds + 69632, ST = lds + 104448;
    const float lg = ret_lg2(h);
    const bf16* RQ = WSP(bf16, WS_RQ); const bf16* RK = WSP(bf16, WS_RK); const bf16* RV = WSP(bf16, WS_RV); const bf16* SRG = WSP(bf16, WS_SRG); bf16* MX = WSP(bf16, WS_MX);
    const float* LTbh = WSP(float, WS_LT) + (size_t)bh * 16 * 128 * 64;
    const size_t row0 = (size_t)b * SEQ + n * 128;
#pragma unroll
    for (int j = 0; j < 2; ++j) { const int idx = tid + 512 * j, pos = idx >> 3, ch = idx & 7;
        *(LAS u32x4*)(AP + pos * 400 + 256 + ch * 16) = *(const u32x4*)(RQ + (row0 + pos) * 512 + h * 64 + ch * 8);
        u32x4 kv = *(const u32x4*)(RK + (row0 + pos) * 512 + h * 64 + ch * 8); const float f = exp2f(-lg * (float)(pos + 1));
        unsigned* kp = (unsigned*)&kv;
#pragma unroll
        for (int e = 0; e < 4; ++e) kp[e] = pkbf(bf_lo(kp[e]) * f, bf_hi(kp[e]) * f);
        *(LAS u32x4*)(Kimg + pos * 144 + ch * 16) = kv; }
#pragma unroll
    for (int j = 0; j < 4; ++j) { const int idx = tid + 512 * j, pos = idx >> 4, ch = idx & 15;
        *(LAS u32x4*)(Vimg + pos * 272 + ch * 16) = *(const u32x4*)(RV + (row0 + pos) * 1024 + h * 128 + ch * 8); }
    {
        const int e = tid & 127, d0 = (tid >> 7) * 16; f32x4 s[4];
        if (n > 0) ret_state_sum(LTbh, n - 1, lg, e, d0, s);
        else {
#pragma unroll
            for (int j = 0; j < 4; ++j) s[j] = (f32x4){0.f, 0.f, 0.f, 0.f}; }
        u32x4 w0, w1; w0.x = pkbf(s[0][0], s[0][1]); w0.y = pkbf(s[0][2], s[0][3]); w0.z = pkbf(s[1][0], s[1][1]); w0.w = pkbf(s[1][2], s[1][3]);
        w1.x = pkbf(s[2][0], s[2][1]); w1.y = pkbf(s[2][2], s[2][3]); w1.z = pkbf(s[3][0], s[3][1]); w1.w = pkbf(s[3][2], s[3][3]);
        *(LAS u32x4*)(ST + e * 144 + d0 * 2) = w0; *(LAS u32x4*)(ST + e * 144 + d0 * 2 + 16) = w1;
        if (n == 15) { ret_state_sum(LTbh, 15, lg, e, d0, s); float* o = A.out + O_RSP + ((size_t)bh * 64 + d0) * 128 + e;
#pragma unroll
            for (int j = 0; j < 4; ++j)
#pragma unroll
                for (int c = 0; c < 4; ++c) o[(size_t)(4 * j + c) * 128] = s[j][c]; }
    }
    __syncthreads();
    const int fr = lane & 15, fq = lane >> 4, lq = 16 * wave + fr;
    {
        const int mtmax = (wave | 1) < 7 ? (wave | 1) : 7;
        for (int mt = 0; mt <= mtmax; ++mt) {
            f32x4 sa = {0.f, 0.f, 0.f, 0.f};
            if (mt <= wave) {
#pragma unroll
                for (int ks = 0; ks < 2; ++ks) sa = MFMA16(frag_row(Kimg, 144, 16 * mt + fr, 32 * ks + 8 * fq), frag_row(AP, 400, lq, 128 + 32 * ks + 8 * fq), sa);
#pragma unroll
                for (int i = 0; i < 4; ++i) if (16 * mt + 4 * fq + i > lq) sa[i] = 0.f;
            }
            u32x2 w; w.x = pkbf(sa[0], sa[1]); w.y = pkbf(sa[2], sa[3]);
            *(LAS u32x2*)(AP + lq * 400 + (16 * mt + 4 * fq) * 2) = w;
        }
    }
    asm volatile("s_waitcnt lgkmcnt(0)" ::: "memory");
    f32x4 acc[8];
#pragma unroll
    for (int et = 0; et < 8; ++et) acc[et] = (f32x4){0.f, 0.f, 0.f, 0.f};
    const int ksmax = (16 * wave + 15) >> 5;
    for (int ks = 0; ks <= ksmax; ++ks) {
        const bf16x8 bp = frag_row(AP, 400, lq, 32 * ks + 8 * fq);
#pragma unroll
        for (int et = 0; et < 8; ++et) acc[et] = MFMA16(frag_tr(Vimg, 272, 32 * ks, 16 * et, lane), bp, acc[et]);
    }
#pragma unroll
    for (int ks = 0; ks < 2; ++ks) {
        const bf16x8 bq = frag_row(AP, 400, lq, 128 + 32 * ks + 8 * fq);
#pragma unroll
        for (int et = 0; et < 8; ++et) acc[et] = MFMA16(frag_row(ST, 144, 16 * et + fr, 32 * ks + 8 * fq), bq, acc[et]);
    }
    {
        const float f = exp2f(lg * (float)(lq + 1));
        float s = 0.f;
#pragma unroll
        for (int et = 0; et < 8; ++et) { acc[et] = acc[et] * f; s += (acc[et][0] + acc[et][1]) + (acc[et][2] + acc[et][3]); }
        s += __shfl_xor(s, 16); s += __shfl_xor(s, 32);
        const float mean = s * (1.f / 128.f); float q = 0.f;
#pragma unroll
        for (int et = 0; et < 8; ++et) { acc[et] = acc[et] - mean; q += (acc[et][0] * acc[et][0] + acc[et][1] * acc[et][1]) + (acc[et][2] * acc[et][2] + acc[et][3] * acc[et][3]); }
        q += __shfl_xor(q, 16); q += __shfl_xor(q, 32);
        const float rstd = 1.0f / sqrtf(q * (1.f / 128.f) + EPS);
        const size_t row = row0 + lq; const float* gr = A.in[12] + h * 128;
#pragma unroll
        for (int et = 0; et < 8; ++et) { const int e0 = 16 * et + 4 * fq;
            const f32x4 g = *(const f32x4*)(gr + e0); const u32x2 sg = *(const u32x2*)(SRG + row * 1024 + h * 128 + e0);
            u32x2 w; w.x = pkbf(acc[et][0] * rstd * g[0] * bf_lo(sg.x), acc[et][1] * rstd * g[1] * bf_hi(sg.x)); w.y = pkbf(acc[et][2] * rstd * g[2] * bf_lo(sg.y), acc[et][3] * rstd * g[3] * bf_hi(sg.y));
            *(u32x2*)(MX + row * WMIX + 512 + h * 128 + e0) = w; }
    }
    __syncthreads();
}
__device__ __forceinline__ void decode_combine(const Args& A, int item, int lane) {
    const int b = item >> 5, h = (item >> 2) & 7, i = item & 3;
    const float* dec = WSP(float, WS_DEC); const float* qs = WSP(float, WS_QS32); const bf16* SFG = WSP(bf16, WS_SFG); bf16* MX = WSP(bf16, WS_MX);
    const float qd = qs[(size_t)(4 * b + i) * 512 + h * 64 + lane];
    float xm[8], pl[8]; float off = 0.f;
#pragma unroll
    for (int g = 7; g >= 0; --g) { const size_t ui = (size_t)(b * 8 + g) * 4 + i; xm[g] = dec[DEC_PM + ui * 8 + h] + off; pl[g] = dec[DEC_PL + ui * 8 + h]; off += dec[DEC_TU + (b * 8 + g) * 8 + h]; }
    float sn[4], cn = 0.f, M = -1e30f;
#pragma unroll
    for (int j = 0; j < 4; ++j) {
        cn += A.out[O_LFS + (size_t)(4 * b + j) * 8 + h] * LOG2E;
        const float d = wave_sum(qd * A.out[O_KS + (size_t)(4 * b + j) * 512 + h * 64 + lane]);
        sn[j] = j <= i ? d - cn : -1e30f; M = fmaxf(M, sn[j]);
    }
#pragma unroll
    for (int g = 0; g < 8; ++g) M = fmaxf(M, xm[g]);
    float L = 0.f, O = 0.f;
#pragma unroll
    for (int g = 0; g < 8; ++g) { const float f = fast_exp2(xm[g] - M); L += pl[g] * f; O += dec[DEC_PO + ((size_t)(b * 8 + g) * 4 + i) * 512 + h * 64 + lane] * f; }
#pragma unroll
    for (int j = 0; j < 4; ++j) { const float f = j <= i ? fast_exp2(sn[j] - M) : 0.f; L += f; O += f * A.out[O_VS + (size_t)(4 * b + j) * 512 + h * 64 + lane]; }
    const size_t row = MP + 4 * b + i;
    MX[row * WMIX + h * 64 + lane] = f2bf1(O / L * bf1(SFG[row * 512 + h * 64 + lane]));
}

__device__ __forceinline__ void spatial_unit(const Args& A, ldsp lds, int n, int g, int tid, int wave, int lane) {
    ldsp Wimg = lds, VNimg = lds + 34816; LAS f32x2* stat = (LAS f32x2*)(lds + 102400);
    const size_t R0 = (size_t)n * 128;
    const bf16* WS = WSP(bf16, WS_WSP) + (size_t)g * 128 * 128; const bf16* GV = WSP(bf16, WS_GV); const bf16* UG = WSP(bf16, WS_UG); bf16* Z = WSP(bf16, WS_Z);
#pragma unroll
    for (int j = 0; j < 4; ++j) { const int idx = tid + 512 * j, t = idx >> 4, ch = idx & 15; *(LAS u32x4*)(Wimg + t * 272 + ch * 16) = *(const u32x4*)(WS + t * 128 + ch * 8); }
    if (tid < 128) { const f32x2* vp = WSP(f32x2, WS_VST) + (R0 + tid) * 32; float s = 0.f, q = 0.f;
#pragma unroll 8
        for (int j = 0; j < 32; ++j) { const f32x2 v = vp[j]; s += v.x; q += v.y; }
        const float mean = s * (1.f / GMW), var = q * (1.f / GMW) - mean * mean;
        stat[tid] = (f32x2){mean, 1.0f / sqrtf(fmaxf(var, 0.f) + EPS)}; }
    __syncthreads();
    const float* gvn = A.in[16] + g * 256;
#pragma unroll
    for (int j = 0; j < 8; ++j) { const int idx = tid + 512 * j, s = idx >> 5, ch = idx & 31;
        const u32x4 x = *(const u32x4*)(GV + (R0 + s) * GMW + g * 256 + ch * 8); const f32x2 ms = stat[s];
        const f32x4 g0 = *(const f32x4*)(gvn + ch * 8), g1 = *(const f32x4*)(gvn + ch * 8 + 4);
        u32x4 w; w.x = pkbf((bf_lo(x.x) - ms.x) * ms.y * g0[0], (bf_hi(x.x) - ms.x) * ms.y * g0[1]); w.y = pkbf((bf_lo(x.y) - ms.x) * ms.y * g0[2], (bf_hi(x.y) - ms.x) * ms.y * g0[3]);
        w.z = pkbf((bf_lo(x.z) - ms.x) * ms.y * g1[0], (bf_hi(x.z) - ms.x) * ms.y * g1[1]); w.w = pkbf((bf_lo(x.w) - ms.x) * ms.y * g1[2], (bf_hi(x.w) - ms.x) * ms.y * g1[3]);
        *(LAS u32x4*)(VNimg + s * 528 + ch * 16) = w; }
    __syncthreads();
    const int wr = wave >> 2, wc = wave & 3, fr = lane & 15, fq = lane >> 4;
    f32x4 acc[4][4];
#pragma unroll
    for (int ct = 0; ct < 4; ++ct)
#pragma unroll
        for (int tt = 0; tt < 4; ++tt) acc[ct][tt] = (f32x4){0.f, 0.f, 0.f, 0.f};
#pragma unroll
    for (int ks = 0; ks < 4; ++ks) {
        if (32 * ks > 64 * wr + 63) continue;
        bf16x8 a[4];
#pragma unroll
        for (int ct = 0; ct < 4; ++ct) a[ct] = frag_tr(VNimg, 528, 32 * ks, 64 * wc + 16 * ct, lane);
#pragma unroll
        for (int tt = 0; tt < 4; ++tt) {
            if (32 * ks > 64 * wr + 16 * tt + 15) continue;
            const bf16x8 bw = frag_row(Wimg, 272, 64 * wr + 16 * tt + fr, 32 * ks + 8 * fq);
#pragma unroll
            for (int ct = 0; ct < 4; ++ct) acc[ct][tt] = MFMA16(a[ct], bw, acc[ct][tt]);
        }
    }
    const float* bs = A.in[18] + g * 128;
#pragma unroll
    for (int tt = 0; tt < 4; ++tt) { const int t = 64 * wr + 16 * tt + fr; const float bt = bs[t]; const size_t row = R0 + t;
#pragma unroll
        for (int ct = 0; ct < 4; ++ct) { const int c = g * 256 + 64 * wc + 16 * ct + 4 * fq;
            const u32x2 ug = *(const u32x2*)(UG + row * GMW + c);
            u32x2 w; w.x = pkbf((acc[ct][tt][0] + bt) * bf_lo(ug.x), (acc[ct][tt][1] + bt) * bf_hi(ug.x)); w.y = pkbf((acc[ct][tt][2] + bt) * bf_lo(ug.y), (acc[ct][tt][3] + bt) * bf_hi(ug.y));
            *(u32x2*)(Z + row * GMW + c) = w; } }
    __syncthreads();
}
__device__ __forceinline__ void spatial_sample_item(const Args& A, int item) {
    const int b = item >> 11, c = item & 2047, g = c >> 8;
    const bf16* GV = WSP(bf16, WS_GV); const bf16* UG = WSP(bf16, WS_UG); bf16* Z = WSP(bf16, WS_Z); const f32x2* VST = WSP(f32x2, WS_VST);
    const float gain = A.in[16][c]; float vn[4];
#pragma unroll
    for (int s = 0; s < 4; ++s) { const size_t row = MP + 4 * b + s; const f32x2* vp = VST + row * 32; float sm = 0.f, q = 0.f;
        for (int j = 0; j < 32; ++j) { const f32x2 v = vp[j]; sm += v.x; q += v.y; }
        const float mean = sm * (1.f / GMW), var = q * (1.f / GMW) - mean * mean, rstd = 1.0f / sqrtf(fmaxf(var, 0.f) + EPS);
        vn[s] = (bf1(GV[row * GMW + c]) - mean) * rstd * gain;
        A.out[O_CV + (size_t)(4 * b + s) * GMW + c] = vn[s]; }
    const float* w = A.in[17] + (size_t)g * 128 * 128; const float* bs = A.in[18] + g * 128;
#pragma unroll
    for (int t = 0; t < 4; ++t) { float sv = bs[t];
#pragma unroll
        for (int s = 0; s < 4; ++s) if (s <= t) sv += w[t * 128 + s] * vn[s];
        const size_t row = MP + 4 * b + t;
        Z[row * GMW + c] = f2bf1(sv * bf1(UG[row * GMW + c])); }
}

__global__ void __launch_bounds__(NWAVES * 64, 2) hybrid_fwd(Args A) {
    extern __shared__ __attribute__((aligned(16))) unsigned char lds_raw[];
    ldsp lds = (ldsp)lds_raw;
    const int tid0 = threadIdx.x;
#define PHASE_IDS() int tid = tid0; asm volatile("" : "+v"(tid)); const int lane = tid & 63, wave = __builtin_amdgcn_readfirstlane(tid >> 6); (void)lane; (void)wave
    const int G = gridDim.x; const int bx = blockIdx.x; const int vcu = (G % 8 == 0) ? (bx % 8) * (G / 8) + bx / 8 : bx;
    volatile LAS unsigned* MISC = (volatile LAS unsigned*)(lds + MISC_OFF);
    if (tid0 < 64) MISC[tid0] = 0u;
    __syncthreads();
    XcdBarrier bar = xcd_barrier_post((unsigned*)(A.ws + WS_CTL) + CW_BAR, MISC + 8);
    const int lo = A.ph_lo, hi = A.ph_hi;
#ifndef PH_MASK
#define PH_MASK 0xFF
#endif
#define IN(k) (((PH_MASK >> (k)) & 1) && lo <= (k) && (k) < hi)
#define SEAM(k) do { if (IN(k) && IN((k) + 1)) xcd_barrier(bar); } while (0)

    if (IN(0)) { PHASE_IDS(); p0_prologue(A, lds, vcu, G, tid, wave, lane); }
    SEAM(0);
    if (IN(1)) { PHASE_IDS();
        pg8::Gemm g{WSP(bf16, WS_XB), WSP(bf16, WS_W1T), MPAD, NIN1, DMODEL}; pg8::StaticOrder S; S.init(MPAD, NIN1, G, bx);
        const float* rope = WSP(float, WS_ROPE);
        EpiEven E{WSP(float, WS_RS1), WSP(bf16, WS_QF), WSP(bf16, WS_KF), WSP(bf16, WS_VF), WSP(bf16, WS_SFG), WSP(bf16, WS_RQ), WSP(bf16, WS_RK), WSP(bf16, WS_RV), WSP(bf16, WS_SRG),
                  A.out, WSP(float, WS_QS32), A.in[10], A.in[11], rope, rope + ROPE_N * 32};
        pg8::gemm_phase<EpiEven, pg8::StaticOrder, true, true>(lds, g, S, E);
    }
    SEAM(1);
    if (IN(2)) {
      { PHASE_IDS();
#ifndef P2_MASK
#define P2_MASK 15
#endif
        if (P2_MASK & 1) for (int u = vcu; u < 256; u += G) {
            const int bh = u >> 2, s = u & 3, b = bh >> 3, h = bh & 7;
            LAS float* ck = (LAS float*)(lds + CK_OFF); LAS float* wt = ck + 2048;
            {
                const float* lf = A.out + O_LFP + ((size_t)b * SEQ + 4 * tid) * 8 + h;
                const float v0 = lf[0] * LOG2E, v1 = v0 + lf[8] * LOG2E, v2 = v1 + lf[16] * LOG2E, v3 = v2 + lf[24] * LOG2E;
                float x = v3;
#pragma unroll
                for (int o = 1; o < 64; o <<= 1) { const float y = __shfl_up(x, o); if (lane >= o) x += y; }
                if (lane == 63) wt[wave] = x;
                __syncthreads();
                float base = x - v3;
                for (int w2 = 0; w2 < wave; ++w2) base += wt[w2];
                *(LAS f32x4*)(ck + 4 * tid) = (f32x4){v0 + base, v1 + base, v2 + base, v3 + base};
                __syncthreads();
            }
            const attn_body::bf16* Q = (const attn_body::bf16*)WSP(bf16, WS_QF); const attn_body::bf16* K = (const attn_body::bf16*)WSP(bf16, WS_KF); const attn_body::bf16* V = (const attn_body::bf16*)WSP(bf16, WS_VF);
            const attn_body::bf16* SG = (const attn_body::bf16*)WSP(bf16, WS_SFG); attn_body::bf16* MXo = (attn_body::bf16*)WSP(bf16, WS_MX);
            attn_body::attn_unit<8>(b, h, s, Q, K, V, SG, MXo, (attn_body::lds_cfptr)ck, (char*)lds_raw);
            attn_body::attn_unit<8>(b, h, 7 - s, Q, K, V, SG, MXo, (attn_body::lds_cfptr)ck, (char*)lds_raw);
            __syncthreads();
        }
      }
      { PHASE_IDS();
        if (P2_MASK & 2) for (int u = vcu; u < 256; u += G) ret_pass_a(A, lds, u >> 2, u & 3, tid, wave, lane);
      }
      { PHASE_IDS();
        if (P2_MASK & 4) for (int u = vcu; u < 256; u += G) ret_sample_unit(A, lds, u, tid, wave, lane);
      }
      { PHASE_IDS();
        if (P2_MASK & 8) for (int u = vcu; u < 256; u += G) decode_unit(A, lds, u >> 3, u & 7, tid, wave, lane);
      }
    }
    SEAM(2);
    if (IN(3)) { PHASE_IDS();
        for (int u = vcu; u < 1024; u += G) ret_pass_c(A, lds, u >> 4, u & 15, tid, wave, lane);
        for (int it = vcu * NWAVES + wave; it < 1024; it += G * NWAVES) decode_combine(A, it, lane);
    }
    SEAM(3);
    if (IN(4)) { PHASE_IDS();
        pg8::Gemm g{WSP(bf16, WS_MX), WSP(bf16, WS_W2T), MPAD, DMODEL, WMIX}; pg8::StaticOrder S; S.init(MPAD, DMODEL, G, bx);
        EpiRes1 E{A.in[0], A.in[1], WSP(float, WS_X1), WSP(bf16, WS_X1B), WSP(float, WS_SSQ)};
        pg8::gemm_phase<EpiRes1, pg8::StaticOrder, true, true>(lds, g, S, E);
    }
    SEAM(4);
    if (IN(5)) { PHASE_IDS();
        pg8::Gemm g{WSP(bf16, WS_X1B), WSP(bf16, WS_W3T), MPAD, NIN3, DMODEL}; pg8::StaticOrder S; S.init(MPAD, NIN3, G, bx);
        EpiOdd E{WSP(float, WS_SSQ), WSP(bf16, WS_UG), WSP(bf16, WS_GV), WSP(f32x2, WS_VST)};
        pg8::gemm_phase<EpiOdd, pg8::StaticOrder, true, true>(lds, g, S, E);
    }
    SEAM(5);
    if (IN(6)) { PHASE_IDS();
        for (int u = vcu; u < 1024; u += G) spatial_unit(A, lds, u >> 3, u & 7, tid, wave, lane);
        for (int it = vcu * NWAVES * 64 + tid; it < 32 * 2048; it += G * NWAVES * 64) spatial_sample_item(A, it);
    }
    SEAM(6);
    if (IN(7)) { PHASE_IDS();
        pg8::Gemm g{WSP(bf16, WS_Z), WSP(bf16, WS_W4T), MPAD, DMODEL, GMW}; pg8::StaticOrder S; S.init(MPAD, DMODEL, G, bx);
        EpiRes2 E{WSP(float, WS_X1), A.out};
        pg8::gemm_phase<EpiRes2, pg8::StaticOrder, true, true>(lds, g, S, E);
    }
#undef IN
#undef SEAM
}

#ifndef MK_N_LAUNCHES
#define MK_N_LAUNCHES 1
#endif
extern "C" void kernel_launch(void* const* d_in, const int* in_sizes, int n_in, void* d_out, int out_size, void* d_ws, size_t ws_size, hipStream_t stream) {
    static int grid = 0;
    if (grid == 0) {
        if (n_in != 20 || (size_t)out_size != O_END || ws_size < WS_END) { fprintf(stderr, "kernel_launch: unexpected shapes: n_in %d out %d ws %zu\n", n_in, out_size, ws_size); grid = -1; return; }
        int dev = 0, cus = 0, per_cu = 0;
        if (hipGetDevice(&dev) != hipSuccess || hipDeviceGetAttribute(&cus, hipDeviceAttributeMultiprocessorCount, dev) != hipSuccess) { grid = -1; return; }
        if (hipFuncSetAttribute((const void*)hybrid_fwd, hipFuncAttributeMaxDynamicSharedMemorySize, LDS_BYTES) != hipSuccess) { fprintf(stderr, "kernel_launch: hipFuncSetAttribute failed\n"); grid = -1; return; }
        if (hipOccupancyMaxActiveBlocksPerMultiprocessor(&per_cu, (const void*)hybrid_fwd, NWAVES * 64, LDS_BYTES) != hipSuccess || per_cu < 1) fprintf(stderr, "kernel_launch: occupancy query says %d\n", per_cu);
        (void)hipGetLastError();
        grid = cus;
    }
    if (grid < 0) return;
    (void)hipMemsetAsync((char*)d_ws + WS_CTL, 0, CTL_ZERO_BYTES, stream);
    Args a{};
    for (int i = 0; i < 20; ++i) a.in[i] = (const float*)d_in[i];
    a.out = (float*)d_out; a.ws = (unsigned char*)d_ws;
#if MK_N_LAUNCHES == 1
    a.ph_lo = 0; a.ph_hi = 8;
    hipLaunchKernelGGL(hybrid_fwd, dim3(grid), dim3(NWAVES * 64), LDS_BYTES, stream, a);
#else
    for (int p = 0; p < 8; ++p) { a.ph_lo = p; a.ph_hi = p + 1; hipLaunchKernelGGL(hybrid_fwd, dim3(grid), dim3(NWAVES * 64), LDS_BYTES, stream, a); }
#endif
}
```
